# Optimizing an MI355X kernel written in HIP

```python
import math
import jax, jax.numpy as jnp
from jax import lax
import numpy as np

D_MODEL = 2048
BATCH = 2
SEQ = 4096
DEPTH = 1

N_HEADS = 8
N_KV = 2
HPG = N_HEADS // N_KV
HEAD_DIM = 128
ATTN_WIDTH = N_HEADS * HEAD_DIM
KV_WIDTH = N_KV * HEAD_DIM
CONV_WIDTH = D_MODEL - ATTN_WIDTH
MIX_WIDTH = ATTN_WIDTH + CONV_WIDTH
CONV_K = 3
N_BRANCH = 3
CMP_LEN = 32
CMP_STRIDE = 16
CMP_HIDDEN = 256
SEL_LEN = 64
SEL_TOPK = 16
WINDOW = 512
Q_BLOCK = 128
N_BUCKETS = 32
MAX_DIST = 128
D_FF = 4 * D_MODEL
EPS = 1e-6
NEG = -1e30
FORCE = 1e9
SPLIT_SIZES = [ATTN_WIDTH] + [KV_WIDTH] * 6 + [N_HEADS * N_BRANCH] + [CONV_WIDTH] * 3
IN_WIDTH = sum(SPLIT_SIZES)

kernel_name = "hymba_nsa_shortconv_sandwich_layer"


def rmsnorm(x, g):
    xf = x.astype(jnp.float32)
    y = xf * lax.rsqrt(jnp.mean(xf * xf, axis=-1, keepdims=True) + EPS)
    return (y * g.astype(jnp.float32)).astype(x.dtype)


def rel_bucket(dist):
    n = jnp.maximum(dist, 0)
    max_exact = N_BUCKETS // 2
    nf = jnp.maximum(n, 1).astype(jnp.float32)
    large = max_exact + (jnp.log(nf / max_exact) / math.log(MAX_DIST / max_exact)
                         * (N_BUCKETS - max_exact)).astype(jnp.int32)
    large = jnp.minimum(large, N_BUCKETS - 1)
    return jnp.where(n < max_exact, n, large)


def masked_softmax(s, valid):
    s = jnp.where(valid, s.astype(jnp.float32), NEG)
    p = jax.nn.softmax(s, axis=-1)
    return jnp.where(valid, p, 0.0)


def compress(raw, pe, w1, w2):
    t = raw.shape[1]
    n_cmp = (t - CMP_LEN) // CMP_STRIDE + 1
    idx = np.arange(n_cmp)[:, None] * CMP_STRIDE + np.arange(CMP_LEN)[None, :]
    blk = raw[:, idx] + pe[None, None, :, None, :]
    hid = jax.nn.silu(jnp.einsum('bclgd,ldh->bcgh', blk, w1))
    return jnp.einsum('bcgh,he->bgce', hid, w2)


def nsa(q, kc, vc, ks, vs, kw, vw, gates, pe, wk1, wk2, wv1, wv2, rel_bias):
    b, t = q.shape[0], q.shape[1]
    scale = HEAD_DIM ** -0.5
    pos = jnp.arange(t)
    qg = q.reshape(b, t, N_KV, HPG, HEAD_DIM).transpose(0, 2, 3, 1, 4)

    kcmp = compress(kc, pe, wk1, wk2)
    vcmp = compress(vc, pe, wv1, wv2)
    n_cmp = kcmp.shape[2]
    blk_end = jnp.arange(n_cmp) * CMP_STRIDE + CMP_LEN - 1
    dist_c = pos[:, None] - blk_end[None, :]
    valid_c = dist_c >= 0
    bias_c = rel_bias[:, rel_bucket(dist_c)].reshape(N_KV, HPG, t, n_cmp)
    s_c = jnp.einsum('bghtd,bgcd->bghtc', qg, kcmp).astype(jnp.float32) * scale + bias_c
    p_c = masked_softmax(s_c, valid_c)
    o_c = jnp.einsum('bghtc,bgcd->bghtd', p_c.astype(vcmp.dtype), vcmp)

    n_sel = t // SEL_LEN
    ci = np.arange(n_cmp)[:, None] * CMP_STRIDE
    sj = np.arange(n_sel)[None, :] * SEL_LEN
    overlap = ((ci < sj + SEL_LEN) & (ci + CMP_LEN > sj)).astype(np.float32)
    imp = jnp.einsum('bghtc,cj->bgtj', p_c, jnp.asarray(overlap))
    j = jnp.arange(n_sel)[None, :]
    cur = (pos // SEL_LEN)[:, None]
    forced = (j == 0) | (j == cur) | (j == cur - 1)
    imp = jnp.where(forced, FORCE, imp)
    imp = jnp.where(j * SEL_LEN <= pos[:, None], imp, NEG)
    k_top = min(SEL_TOPK, n_sel)
    _, sel_idx = lax.top_k(imp, k_top)

    ks_blk = ks.transpose(0, 2, 1, 3).reshape(b, N_KV, n_sel, SEL_LEN, HEAD_DIM)
    vs_blk = vs.transpose(0, 2, 1, 3).reshape(b, N_KV, n_sel, SEL_LEN, HEAD_DIM)
    kw_pad = jnp.pad(kw.transpose(0, 2, 1, 3), ((0, 0), (0, 0), (WINDOW, 0), (0, 0)))
    vw_pad = jnp.pad(vw.transpose(0, 2, 1, 3), ((0, 0), (0, 0), (WINDOW, 0), (0, 0)))

    rel_bias_g = rel_bias.reshape(N_KV, HPG, N_BUCKETS)
    bi = jnp.arange(b)[:, None, None, None]
    gi = jnp.arange(N_KV)[None, :, None, None]
    gi5 = jnp.arange(N_KV)[None, :, None, None, None]
    hi5 = jnp.arange(HPG)[None, None, :, None, None]
    kv_len = Q_BLOCK + WINDOW
    dist_w = WINDOW + jnp.arange(Q_BLOCK)[:, None] - jnp.arange(kv_len)[None, :]
    band = (dist_w >= 0) & (dist_w < WINDOW)
    bias_w = rel_bias[:, rel_bucket(dist_w)].reshape(N_KV, HPG, Q_BLOCK, kv_len)

    def block_fn(c):
        start = c * Q_BLOCK
        qb = lax.dynamic_slice_in_dim(qg, start, Q_BLOCK, axis=3)
        tq = start + jnp.arange(Q_BLOCK)
        idx = lax.dynamic_slice_in_dim(sel_idx, start, Q_BLOCK, axis=2)
        kb = ks_blk[bi, gi, idx].reshape(b, N_KV, Q_BLOCK, k_top * SEL_LEN, HEAD_DIM)
        vb = vs_blk[bi, gi, idx].reshape(b, N_KV, Q_BLOCK, k_top * SEL_LEN, HEAD_DIM)
        spos = (idx[..., None] * SEL_LEN + jnp.arange(SEL_LEN)).reshape(b, N_KV, Q_BLOCK, k_top * SEL_LEN)
        dist_s = tq[None, None, :, None] - spos
        valid_s = (dist_s >= 0)[:, :, None]
        bias_s = rel_bias_g[gi5, hi5, rel_bucket(dist_s)[:, :, None]]
        s_s = jnp.einsum('bghqd,bgqsd->bghqs', qb, kb).astype(jnp.float32) * scale + bias_s
        p_s = masked_softmax(s_s, valid_s)
        o_s = jnp.einsum('bghqs,bgqsd->bghqd', p_s.astype(vb.dtype), vb)
        kwb = lax.dynamic_slice_in_dim(kw_pad, start, kv_len, axis=2)
        vwb = lax.dynamic_slice_in_dim(vw_pad, start, kv_len, axis=2)
        kpos = start - WINDOW + jnp.arange(kv_len)
        valid_w = band & (kpos >= 0)[None, :]
        s_w = jnp.einsum('bghqd,bgkd->bghqk', qb, kwb).astype(jnp.float32) * scale + bias_w
        p_w = masked_softmax(s_w, valid_w)
        o_w = jnp.einsum('bghqk,bgkd->bghqd', p_w.astype(vwb.dtype), vwb)
        return o_s, o_w

    n_blocks = t // Q_BLOCK
    o_s, o_w = lax.map(block_fn, jnp.arange(n_blocks))

    def unblock(o):
        return o.transpose(1, 2, 3, 0, 4, 5).reshape(b, N_KV, HPG, t, HEAD_DIM)

    def to_bthd(o):
        return o.transpose(0, 3, 1, 2, 4).reshape(b, t, N_HEADS, HEAD_DIM)

    o_c, o_s, o_w = to_bthd(o_c), to_bthd(unblock(o_s)), to_bthd(unblock(o_w))
    g = gates.astype(o_c.dtype)
    o = g[..., 0:1] * o_c + g[..., 1:2] * o_s + g[..., 2:3] * o_w
    return o.reshape(b, t, ATTN_WIDTH)


def short_conv(h, bg, cg, w):
    u = cg * h
    t = u.shape[1]
    up = jnp.pad(u, ((0, 0), (CONV_K - 1, 0), (0, 0)))
    y = w[0] * up[:, 0:t]
    for k in range(1, CONV_K):
        y = y + w[k] * up[:, k:k + t]
    return bg * y


def setup_inputs(seed: int = 0) -> dict:
    key = jax.random.key(seed)
    ks = jax.random.split(key, 20)
    L = DEPTH
    nrm = lambda k, shape, s: jax.random.normal(k, shape, jnp.float32) * s
    gain = lambda k: 1.0 + 0.02 * jax.random.normal(k, (L, D_MODEL), jnp.float32)
    return {
        "x": nrm(ks[0], (BATCH, SEQ, D_MODEL), 1.0),
        "w_in": nrm(ks[1], (L, D_MODEL, IN_WIDTH), D_MODEL ** -0.5),
        "pe_cmp": nrm(ks[2], (L, CMP_LEN, HEAD_DIM), 0.02),
        "w_cmp_k1": nrm(ks[3], (L, CMP_LEN, HEAD_DIM, CMP_HIDDEN), (CMP_LEN * HEAD_DIM) ** -0.5),
        "w_cmp_k2": nrm(ks[4], (L, CMP_HIDDEN, HEAD_DIM), CMP_HIDDEN ** -0.5),
        "w_cmp_v1": nrm(ks[5], (L, CMP_LEN, HEAD_DIM, CMP_HIDDEN), (CMP_LEN * HEAD_DIM) ** -0.5),
        "w_cmp_v2": nrm(ks[6], (L, CMP_HIDDEN, HEAD_DIM), CMP_HIDDEN ** -0.5),
        "conv_w": nrm(ks[7], (L, CONV_K, CONV_WIDTH), CONV_K ** -0.5),
        "rel_bias": nrm(ks[8], (N_HEADS, N_BUCKETS), 0.5),
        "w_o": nrm(ks[9], (L, MIX_WIDTH, D_MODEL), MIX_WIDTH ** -0.5),
        "w_up": nrm(ks[10], (L, D_MODEL, D_FF), D_MODEL ** -0.5),
        "w_down": nrm(ks[11], (L, D_FF, D_MODEL), D_FF ** -0.5),
        "g_pre_mix": gain(ks[12]),
        "g_post_mix": gain(ks[13]),
        "g_pre_ffn": gain(ks[14]),
        "g_post_ffn": gain(ks[15]),
    }


def reference(x, w_in, pe_cmp, w_cmp_k1, w_cmp_k2, w_cmp_v1, w_cmp_v2, conv_w, rel_bias,
              w_o, w_up, w_down, g_pre_mix, g_post_mix, g_pre_ffn, g_post_ffn):
    b, t, _ = x.shape
    offsets = np.cumsum(SPLIT_SIZES)[:-1].tolist()
    for l in range(DEPTH):
        h = rmsnorm(x, g_pre_mix[l])
        proj = h @ w_in[l]
        q, kc, vc, ksl, vsl, kwn, vwn, gl, ch, cb, cc = jnp.split(proj, offsets, axis=-1)
        kv = lambda a: a.reshape(b, t, N_KV, HEAD_DIM)
        gates = jax.nn.sigmoid(gl.astype(jnp.float32)).reshape(b, t, N_HEADS, N_BRANCH)
        o_attn = nsa(q.reshape(b, t, N_HEADS, HEAD_DIM), kv(kc), kv(vc), kv(ksl), kv(vsl),
                     kv(kwn), kv(vwn), gates, pe_cmp[l], w_cmp_k1[l], w_cmp_k2[l],
                     w_cmp_v1[l], w_cmp_v2[l], rel_bias)
        o_conv = short_conv(ch, cb, cc, conv_w[l])
        mix = jnp.concatenate([o_attn, o_conv], axis=-1) @ w_o[l]
        x = x + rmsnorm(mix, g_post_mix[l])
        h = rmsnorm(x, g_pre_ffn[l])
        f = jnp.square(jax.nn.relu(h @ w_up[l])) @ w_down[l]
        x = x + rmsnorm(f, g_post_ffn[l])
    return x
```

```cpp
#include <hip/hip_runtime.h>
#include <stdint.h>

constexpr int B_ = 2, T_ = 4096, D_ = 2048, M_ = B_ * T_;
constexpr int NKV = 2, HD = 128;
constexpr int NCMP = 255, NSEL = 64, TOPK = 16, WIN = 512;
constexpr int DFF = 8192, INW = 5656;
constexpr float EPS = 1e-6f, NEGV = -1e30f, FORCEV = 1e9f;
constexpr int OQ = 0, OKC = 1024, OVC = 1280, OKS = 1536, OVS = 1792, OKW = 2048, OVW = 2304, OGL = 2560, OCH = 2584, OCB = 3608, OCC = 4632;

__device__ __constant__ unsigned char BUCKET_TAB[128] = {
  0, 1, 2, 3, 4, 5, 6, 7, 8, 9, 10, 11, 12, 13, 14, 15, 16, 16, 16, 17, 17, 18, 18, 18, 19, 19, 19, 20, 20, 20, 20, 21, 21, 21, 21, 22, 22, 22, 22, 22,
  23, 23, 23, 23, 23, 23, 24, 24, 24, 24, 24, 24, 25, 25, 25, 25, 25, 25, 25, 26, 26, 26, 26, 26, 26, 26, 26, 27, 27, 27, 27, 27, 27, 27, 27, 27, 27,
  28, 28, 28, 28, 28, 28, 28, 28, 28, 28, 29, 29, 29, 29, 29, 29, 29, 29, 29, 29, 29, 29, 30, 30, 30, 30, 30, 30, 30, 30, 30, 30, 30, 30, 30, 30,
  31, 31, 31, 31, 31, 31, 31, 31, 31, 31, 31, 31, 31, 31, 31};
__device__ __forceinline__ int rel_bucket(int dist) { int n = dist < 0 ? 0 : dist; return n >= 113 ? 31 : (int)BUCKET_TAB[n]; }

__device__ __forceinline__ float block_max(float v, float* red) {
  for (int o = 32; o > 0; o >>= 1) v = fmaxf(v, __shfl_xor(v, o));
  __syncthreads();
  if ((threadIdx.x & 63) == 0) red[threadIdx.x >> 6] = v;
  __syncthreads();
  return fmaxf(fmaxf(red[0], red[1]), fmaxf(red[2], red[3]));
}
__device__ __forceinline__ float block_sum(float v, float* red) {
  for (int o = 32; o > 0; o >>= 1) v += __shfl_xor(v, o);
  __syncthreads();
  if ((threadIdx.x & 63) == 0) red[threadIdx.x >> 6] = v;
  __syncthreads();
  return (red[0] + red[1]) + (red[2] + red[3]);
}

__global__ __launch_bounds__(256) void rstd_rows(const float* x, float* rstd, int ncol) {
  __shared__ float red[4];
  const float* r = x + (size_t)blockIdx.x * ncol;
  float s = 0.f;
  for (int i = threadIdx.x; i < ncol; i += 256) { float v = r[i]; s += v * v; }
  s = block_sum(s, red);
  if (threadIdx.x == 0) rstd[blockIdx.x] = rsqrtf(s / (float)ncol + EPS);
}

template <int MODE>
__global__ __launch_bounds__(256) void gemm_naive(const float* A, int lda, const float* rowscale, const float* colgain,
                                                  const float* Bm, int ldb, float* C, int ldc, int M, int N, int K) {
  __shared__ float As[16][68];
  __shared__ float Bs[16][68];
  const int tid = threadIdx.x, tx = tid & 15, ty = tid >> 4;
  const int m0 = blockIdx.y * 64, n0 = blockIdx.x * 64;
  float acc[4][4];
#pragma unroll
  for (int i = 0; i < 4; ++i)
#pragma unroll
    for (int j = 0; j < 4; ++j) acc[i][j] = 0.f;
  for (int k0 = 0; k0 < K; k0 += 16) {
#pragma unroll
    for (int i = 0; i < 4; ++i) {
      const int idx = tid + i * 256, r = idx >> 4, kk = idx & 15;
      float a = A[(size_t)(m0 + r) * lda + k0 + kk];
      if (rowscale) a = a * rowscale[m0 + r];
      if (colgain) a = a * colgain[k0 + kk];
      As[kk][r] = a;
    }
#pragma unroll
    for (int i = 0; i < 4; ++i) {
      const int idx = tid + i * 256, kk = idx >> 6, c = idx & 63, n = n0 + c;
      Bs[kk][c] = n < N ? Bm[(size_t)(k0 + kk) * ldb + n] : 0.f;
    }
    __syncthreads();
#pragma unroll
    for (int kk = 0; kk < 16; ++kk) {
      float a[4], b[4];
#pragma unroll
      for (int i = 0; i < 4; ++i) a[i] = As[kk][ty * 4 + i];
#pragma unroll
      for (int j = 0; j < 4; ++j) b[j] = Bs[kk][tx * 4 + j];
#pragma unroll
      for (int i = 0; i < 4; ++i)
#pragma unroll
        for (int j = 0; j < 4; ++j) acc[i][j] += a[i] * b[j];
    }
    __syncthreads();
  }
#pragma unroll
  for (int i = 0; i < 4; ++i)
#pragma unroll
    for (int j = 0; j < 4; ++j) {
      const int r = m0 + ty * 4 + i, c = n0 + tx * 4 + j;
      if (c < N) {
        float v = acc[i][j];
        if (MODE == 1) { v = v > 0.f ? v : 0.f; v = v * v; }
        float* p = C + (size_t)r * ldc + c;
        if (MODE == 2) v += *p;
        *p = v;
      }
    }
}

__global__ __launch_bounds__(256) void compress_naive(const float* proj, const float* pe, const float* wk1, const float* wk2,
                                                      const float* wv1, const float* wv2, float* kcmp, float* vcmp) {
  int id = blockIdx.x;
  const int c = id % NCMP; id /= NCMP;
  const int g = id % NKV; id /= NKV;
  const int b = id % B_; const int kv = id / B_;
  const float* w1 = kv ? wv1 : wk1; const float* w2 = kv ? wv2 : wk2;
  float* out = kv ? vcmp : kcmp;
  const int coloff = (kv ? OVC : OKC) + g * HD;
  __shared__ float blk[4096];
  __shared__ float hid[256];
  const int tid = threadIdx.x;
  for (int i = tid; i < 4096; i += 256) {
    const int l = i >> 7, d = i & 127;
    blk[i] = proj[(size_t)(b * T_ + 16 * c + l) * INW + coloff + d] + pe[l * HD + d];
  }
  __syncthreads();
  float s = 0.f;
  for (int k = 0; k < 4096; ++k) s += blk[k] * w1[(size_t)k * 256 + tid];
  hid[tid] = s / (1.f + expf(-s));
  __syncthreads();
  if (tid < HD) {
    float o = 0.f;
    for (int h = 0; h < 256; ++h) o += hid[h] * w2[h * HD + tid];
    out[((size_t)(b * NKV + g) * NCMP + c) * HD + tid] = o;
  }
}

__device__ __forceinline__ float sigmoidf_(float v) { return 1.f / (1.f + expf(-v)); }

__global__ __launch_bounds__(256) void cmp_attn_naive(const float* proj, const float* kcmp, const float* vcmp, const float* rel_bias,
                                                      float* AO, unsigned long long* selmask) {
  const int id = blockIdx.x, t = id % T_, g = (id / T_) % NKV, b = id / (T_ * NKV);
  const int tid = threadIdx.x;
  const size_t row = (size_t)b * T_ + t;
  __shared__ float q[4][HD];
  __shared__ float p[4][256];
  __shared__ float red[4];
  __shared__ float impv[64];
  for (int i = tid; i < 512; i += 256) q[i >> 7][i & 127] = proj[row * INW + OQ + (g * 4 + (i >> 7)) * HD + (i & 127)];
  __syncthreads();
  const int c = tid;
  const bool valid = (c < NCMP) && (16 * c + 31 <= t);
  float s[4] = {NEGV, NEGV, NEGV, NEGV};
  if (valid) {
    const int bk = rel_bucket(t - (16 * c + 31));
    const float* kr = kcmp + ((size_t)(b * NKV + g) * NCMP + c) * HD;
    float a0 = 0.f, a1 = 0.f, a2 = 0.f, a3 = 0.f;
    for (int d = 0; d < HD; ++d) { const float kvv = kr[d]; a0 += q[0][d] * kvv; a1 += q[1][d] * kvv; a2 += q[2][d] * kvv; a3 += q[3][d] * kvv; }
    const float scale = 0.08838834764831845f;
    s[0] = a0 * scale + rel_bias[(g * 4 + 0) * 32 + bk];
    s[1] = a1 * scale + rel_bias[(g * 4 + 1) * 32 + bk];
    s[2] = a2 * scale + rel_bias[(g * 4 + 2) * 32 + bk];
    s[3] = a3 * scale + rel_bias[(g * 4 + 3) * 32 + bk];
  }
#pragma unroll
  for (int h = 0; h < 4; ++h) {
    const float m = block_max(s[h], red);
    const float e = valid ? expf(s[h] - m) : 0.f;
    const float l = block_sum(e, red);
    p[h][c] = valid ? e / l : 0.f;
  }
  __syncthreads();
  {
    const int d = tid & 127, hp = tid >> 7;
    const float* vb = vcmp + (size_t)(b * NKV + g) * NCMP * HD;
    float o0 = 0.f, o1 = 0.f;
    for (int cc = 0; cc < NCMP; ++cc) { const float vv = vb[cc * HD + d]; o0 += p[hp * 2][cc] * vv; o1 += p[hp * 2 + 1][cc] * vv; }
    const int h0 = g * 4 + hp * 2;
    const float g0 = sigmoidf_(proj[row * INW + OGL + h0 * 3 + 0]);
    const float g1 = sigmoidf_(proj[row * INW + OGL + (h0 + 1) * 3 + 0]);
    AO[row * 2048 + h0 * HD + d] = g0 * o0;
    AO[row * 2048 + (h0 + 1) * HD + d] = g1 * o1;
  }
  if (tid < 64) {
    const int j = tid, cur = t >> 6;
    float v = 0.f;
    for (int h = 0; h < 4; ++h)
      for (int cc = 4 * j - 1; cc <= 4 * j + 3; ++cc)
        if (cc >= 0 && cc < NCMP) v += p[h][cc];
    if (j == 0 || j == cur || j == cur - 1) v = FORCEV;
    if (j * 64 > t) v = NEGV;
    int rank = 0;
    for (int i = 0; i < 64; ++i) { const float vi = __shfl(v, i); rank += (vi > v || (vi == v && i < j)) ? 1 : 0; }
    const unsigned long long mk = __ballot(rank < TOPK);
    if (tid == 0) selmask[(size_t)(b * NKV + g) * T_ + t] = mk;
  }
}

template <int MODE>
__global__ __launch_bounds__(256) void attn_naive(const float* proj, const float* rel_bias, const unsigned long long* selmask, float* AO) {
  const int id = blockIdx.x, t = id % T_, g = (id / T_) % NKV, b = id / (T_ * NKV);
  const int tid = threadIdx.x;
  const size_t row = (size_t)b * T_ + t;
  __shared__ float q[4][HD];
  __shared__ float sc[4][1024];
  __shared__ float red[4];
  __shared__ int blist[16];
  __shared__ int nblk;
  const int kcol = (MODE ? OKW : OKS) + g * HD, vcol = (MODE ? OVW : OVS) + g * HD;
  for (int i = tid; i < 512; i += 256) q[i >> 7][i & 127] = proj[row * INW + OQ + (g * 4 + (i >> 7)) * HD + (i & 127)];
  if (MODE == 0 && tid == 0) {
    const unsigned long long mk = selmask[(size_t)(b * NKV + g) * T_ + t];
    int n = 0;
    for (int j = 0; j < NSEL; ++j) if (((mk >> j) & 1ull) && j * 64 <= t && n < 16) blist[n++] = j;
    nblk = n;
  }
  __syncthreads();
  const int kstart = t - (WIN - 1) < 0 ? 0 : t - (WIN - 1);
  const int nkeys = MODE ? (t - kstart + 1) : nblk * 64;
  const float scale = 0.08838834764831845f;
  for (int i = tid; i < nkeys; i += 256) {
    const int pos = MODE ? (kstart + i) : (blist[i >> 6] * 64 + (i & 63));
    const bool valid = pos <= t;
    float s0 = NEGV, s1 = NEGV, s2 = NEGV, s3 = NEGV;
    if (valid) {
      const float* kr = proj + ((size_t)b * T_ + pos) * INW + kcol;
      float a0 = 0.f, a1 = 0.f, a2 = 0.f, a3 = 0.f;
      for (int d = 0; d < HD; ++d) { const float kvv = kr[d]; a0 += q[0][d] * kvv; a1 += q[1][d] * kvv; a2 += q[2][d] * kvv; a3 += q[3][d] * kvv; }
      const int bk = rel_bucket(t - pos);
      s0 = a0 * scale + rel_bias[(g * 4 + 0) * 32 + bk];
      s1 = a1 * scale + rel_bias[(g * 4 + 1) * 32 + bk];
      s2 = a2 * scale + rel_bias[(g * 4 + 2) * 32 + bk];
      s3 = a3 * scale + rel_bias[(g * 4 + 3) * 32 + bk];
    }
    sc[0][i] = s0; sc[1][i] = s1; sc[2][i] = s2; sc[3][i] = s3;
  }
  __syncthreads();
#pragma unroll
  for (int h = 0; h < 4; ++h) {
    float m = NEGV;
    for (int i = tid; i < nkeys; i += 256) m = fmaxf(m, sc[h][i]);
    m = block_max(m, red);
    float l = 0.f;
    for (int i = tid; i < nkeys; i += 256) { const float sv = sc[h][i]; const float e = (sv > -1e29f) ? expf(sv - m) : 0.f; sc[h][i] = e; l += e; }
    l = block_sum(l, red);
    const float inv = 1.f / l;
    for (int i = tid; i < nkeys; i += 256) sc[h][i] *= inv;
  }
  __syncthreads();
  {
    const int d = tid & 127, hp = tid >> 7;
    float o0 = 0.f, o1 = 0.f;
    for (int i = 0; i < nkeys; ++i) {
      const int pos = MODE ? (kstart + i) : (blist[i >> 6] * 64 + (i & 63));
      if (pos <= t) {
        const float vv = proj[((size_t)b * T_ + pos) * INW + vcol + d];
        o0 += sc[hp * 2][i] * vv; o1 += sc[hp * 2 + 1][i] * vv;
      }
    }
    const int h0 = g * 4 + hp * 2, br = MODE ? 2 : 1;
    const float g0 = sigmoidf_(proj[row * INW + OGL + h0 * 3 + br]);
    const float g1 = sigmoidf_(proj[row * INW + OGL + (h0 + 1) * 3 + br]);
    AO[row * 2048 + h0 * HD + d] += g0 * o0;
    AO[row * 2048 + (h0 + 1) * HD + d] += g1 * o1;
  }
}

__global__ __launch_bounds__(256) void conv_naive(const float* proj, const float* conv_w, float* AO) {
  const size_t idx = (size_t)blockIdx.x * 256 + threadIdx.x;
  const int c = (int)(idx & 1023); const size_t row = idx >> 10; const int t = (int)(row % T_);
  const float* pr = proj + row * INW;
  float u2 = pr[OCC + c] * pr[OCH + c];
  float u1 = 0.f, u0 = 0.f;
  if (t >= 1) { const float* p1 = pr - INW; u1 = p1[OCC + c] * p1[OCH + c]; }
  if (t >= 2) { const float* p2 = pr - 2 * INW; u0 = p2[OCC + c] * p2[OCH + c]; }
  float y = conv_w[c] * u0;
  y = y + conv_w[1024 + c] * u1;
  y = y + conv_w[2048 + c] * u2;
  AO[row * 2048 + 1024 + c] = pr[OCB + c] * y;
}

__global__ __launch_bounds__(256) void norm_residual(const float* src, const float* base, const float* gain, float* out, float* rstd_out) {
  __shared__ float red[4];
  const size_t off = (size_t)blockIdx.x * D_;
  float v[8]; float s = 0.f;
#pragma unroll
  for (int i = 0; i < 8; ++i) { v[i] = src[off + threadIdx.x + i * 256]; s += v[i] * v[i]; }
  s = block_sum(s, red);
  const float r = rsqrtf(s / (float)D_ + EPS);
  float s2 = 0.f;
#pragma unroll
  for (int i = 0; i < 8; ++i) {
    const int col = threadIdx.x + i * 256;
    const float y = (v[i] * r) * gain[col];
    const float o = base[off + col] + y;
    out[off + col] = o; s2 += o * o;
  }
  if (rstd_out) {
    s2 = block_sum(s2, red);
    if (threadIdx.x == 0) rstd_out[blockIdx.x] = rsqrtf(s2 / (float)D_ + EPS);
  }
}

extern "C" void kernel_launch(void* const* d_in, const int* in_sizes, int n_in, void* d_out, int out_size, void* d_ws, size_t ws_size,
                              hipStream_t stream) {
  const float* x = (const float*)d_in[0];
  const float* w_in = (const float*)d_in[1];
  const float* pe = (const float*)d_in[2];
  const float* wk1 = (const float*)d_in[3];
  const float* wk2 = (const float*)d_in[4];
  const float* wv1 = (const float*)d_in[5];
  const float* wv2 = (const float*)d_in[6];
  const float* conv_w = (const float*)d_in[7];
  const float* rel_bias = (const float*)d_in[8];
  const float* w_o = (const float*)d_in[9];
  const float* w_up = (const float*)d_in[10];
  const float* w_down = (const float*)d_in[11];
  const float* g_pre_mix = (const float*)d_in[12];
  const float* g_post_mix = (const float*)d_in[13];
  const float* g_pre_ffn = (const float*)d_in[14];
  const float* g_post_ffn = (const float*)d_in[15];
  float* out = (float*)d_out;
  char* ws = (char*)d_ws;
  const size_t MiB = 1u << 20;
  float* rstd1 = (float*)(ws + 0);
  float* rstd2 = (float*)(ws + 32768);
  float* kcmp = (float*)(ws + 65536);
  float* vcmp = (float*)(ws + 65536 + 524288);
  unsigned long long* selmask = (unsigned long long*)(ws + 65536 + 2 * 524288);
  float* PROJ = (float*)(ws + 2 * MiB);
  float* AO = (float*)(ws + 180 * MiB);
  float* U = (float*)(ws + 2 * MiB);
  float* F = (float*)(ws + 66 * MiB);

  rstd_rows<<<M_, 256, 0, stream>>>(x, rstd1, D_);
  gemm_naive<0><<<dim3((INW + 63) / 64, M_ / 64), 256, 0, stream>>>(x, D_, rstd1, g_pre_mix, w_in, INW, PROJ, INW, M_, INW, D_);
  compress_naive<<<2 * B_ * NKV * NCMP, 256, 0, stream>>>(PROJ, pe, wk1, wk2, wv1, wv2, kcmp, vcmp);
  cmp_attn_naive<<<B_ * NKV * T_, 256, 0, stream>>>(PROJ, kcmp, vcmp, rel_bias, AO, selmask);
  attn_naive<0><<<B_ * NKV * T_, 256, 0, stream>>>(PROJ, rel_bias, selmask, AO);
  attn_naive<1><<<B_ * NKV * T_, 256, 0, stream>>>(PROJ, rel_bias, selmask, AO);
  conv_naive<<<(M_ * 1024) / 256, 256, 0, stream>>>(PROJ, conv_w, AO);
  gemm_naive<0><<<dim3(D_ / 64, M_ / 64), 256, 0, stream>>>(AO, 2048, nullptr, nullptr, w_o, D_, out, D_, M_, D_, 2048);
  norm_residual<<<M_, 256, 0, stream>>>(out, x, g_post_mix, out, rstd2);
  for (int j = 0; j < 4; ++j) {
    gemm_naive<1><<<dim3(2048 / 64, M_ / 64), 256, 0, stream>>>(out, D_, rstd2, g_pre_ffn, w_up + j * 2048, DFF, U, 2048, M_, 2048, D_);
    if (j == 0)
      gemm_naive<0><<<dim3(D_ / 64, M_ / 64), 256, 0, stream>>>(U, 2048, nullptr, nullptr, w_down + (size_t)j * 2048 * D_, D_, F, D_, M_, D_, 2048);
    else
      gemm_naive<2><<<dim3(D_ / 64, M_ / 64), 256, 0, stream>>>(U, 2048, nullptr, nullptr, w_down + (size_t)j * 2048 * D_, D_, F, D_, M_, D_, 2048);
  }
  norm_residual<<<M_, 256, 0, stream>>>(F, out, g_post_ffn, out, nullptr);
}
```

```cpp
#include <hip/hip_runtime.h>
#include <cstdio>
#include <cstdint>
namespace pg8 {
#define PG8_LAS __attribute__((address_space(3)))
typedef unsigned short bf16_t;
typedef short bf16x8 __attribute__((ext_vector_type(8)));
typedef float f32x4 __attribute__((ext_vector_type(4)));
typedef unsigned u32x4 __attribute__((ext_vector_type(4)));
constexpr int BM = 256, BK = 64, HALF = 128, HTB = HALF * BK * 2  , STAGE_BYTES = 8 * HTB, NXCD = 8, WGM = 8;

__host__ __device__ __forceinline__ int lds_byte(int r, int c) { const int st = (r >> 4) * 2 + (c >> 5), rr = r & 15, cc = c & 31, ob = rr * 64 + cc * 2; return st * 1024 + (ob ^ (((ob >> 9) & 1) << 5)); }
__host__ __device__ __forceinline__ void stage_rc(int b, int& R, int& C) { const int st = b / 1024, sb = b % 1024, swz = sb ^ (((sb >> 9) & 1) << 5); R = (st >> 1) * 16 + swz / 64; C = (st & 1) * 32 + (swz % 64) / 2; }
__host__ __device__ __forceinline__ int perm32(int rho) { const int n = rho >> 4, i = rho & 15; return 8 * (i >> 2) + 4 * n + (i & 3); }

struct Unit { int pm, pn; };
struct Gemm { const bf16_t* A; const bf16_t* Bt; int M, N, K, lda, ldb; };

struct StaticOrder {
    int nM, nN, nwg, G, c;
    __host__ __device__ void init(int M, int N, int G_, int c_) { nM = M / BM; nN = N / BM; nwg = nM * nN; G = G_; c = c_; }
    __host__ __device__ bool next(int i, Unit& u) const {
        const long L = (long)i * G + c; if (L >= nwg) return false;
        int wgid = (int)L; { const int q = nwg / NXCD, r = nwg % NXCD, xcd = wgid % NXCD, off = wgid / NXCD; wgid = (xcd < r ? xcd * (q + 1) : r * (q + 1) + (xcd - r) * q) + off; }
        const int nig = WGM * nN, gid = wgid / nig, fm = gid * WGM, gsz = (nM - fm) < WGM ? (nM - fm) : WGM;
        u.pm = fm + ((wgid % nig) % gsz); u.pn = (wgid % nig) / gsz; return true;
    }
    __device__ __forceinline__ void a_ready(const Unit&) const {}
    __device__ __forceinline__ void done(const Unit&) const {}
};

__device__ __forceinline__ unsigned cvt_pk_bf16(float lo, float hi) { unsigned r; asm volatile("v_cvt_pk_bf16_f32 %0, %1, %2" : "=v"(r) : "v"(lo), "v"(hi)); return r; }
typedef float f32x2 __attribute__((ext_vector_type(2)));
struct EpiF32 {
    static constexpr bool PERM = false, AFTER_DRAIN = false;
    float* C; int ldc;
    __device__ __forceinline__ void operator()(const f32x4 (&acc)[2][2][4][2], const Unit& u, int wr, int wc, int fr, int fq) const {
        const int row0 = u.pm * BM + wr * 64 + fr, col0 = u.pn * BM + wc * 32 + 4 * fq;
#pragma unroll
        for (int ai = 0; ai < 2; ++ai)
#pragma unroll
            for (int m = 0; m < 4; ++m) { float* rowp = C + (size_t)(row0 + ai * HALF + m * 16) * ldc + col0;
#pragma unroll
                for (int bj = 0; bj < 2; ++bj)
#pragma unroll
                    for (int n = 0; n < 2; ++n) *(f32x4*)(rowp + bj * HALF + n * 16) = acc[ai][bj][m][n]; }
    }
};
struct EpiRelu2Bf16 {
    static constexpr bool PERM = true, AFTER_DRAIN = false;
    bf16_t* O; int ldc;
    __device__ __forceinline__ void operator()(const f32x4 (&acc)[2][2][4][2], const Unit& u, int wr, int wc, int fr, int fq) const {
        const int row0 = u.pm * BM + wr * 64 + fr, col0 = u.pn * BM + wc * 32 + 8 * fq;
#pragma unroll
        for (int ai = 0; ai < 2; ++ai)
#pragma unroll
            for (int m = 0; m < 4; ++m) { bf16_t* rowp = O + (size_t)(row0 + ai * HALF + m * 16) * ldc + col0;
#pragma unroll
                for (int bj = 0; bj < 2; ++bj) { f32x4 v0 = acc[ai][bj][m][0], v1 = acc[ai][bj][m][1];
#pragma unroll
                    for (int e = 0; e < 4; ++e) { v0[e] = v0[e] > 0.f ? v0[e] : 0.f; v1[e] = v1[e] > 0.f ? v1[e] : 0.f; }
                    v0 = v0 * v0; v1 = v1 * v1;
                    u32x4 w; w.x = cvt_pk_bf16(v0[0], v0[1]); w.y = cvt_pk_bf16(v0[2], v0[3]); w.z = cvt_pk_bf16(v1[0], v1[1]); w.w = cvt_pk_bf16(v1[2], v1[3]);
                    *(u32x4*)(rowp + bj * HALF) = w; } }
    }
};
struct EpiInProj {
    static constexpr bool PERM = true, AFTER_DRAIN = false;
    bf16_t* Q; bf16_t* KV; bf16_t* C3; float* gates; float qscale;
    __device__ __forceinline__ void operator()(const f32x4 (&acc)[2][2][4][2], const Unit& u, int wr, int wc, int fr, int fq) const {
        const int pn = u.pn;
        const int row0 = u.pm * BM + wr * 64 + fr, cc0 = wc * 32 + 8 * fq;
#pragma unroll
        for (int ai = 0; ai < 2; ++ai)
#pragma unroll
            for (int m = 0; m < 4; ++m) { const int r = row0 + ai * HALF + m * 16;
#pragma unroll
                for (int bj = 0; bj < 2; ++bj) { f32x4 v0 = acc[ai][bj][m][0], v1 = acc[ai][bj][m][1];
                    const int cc = cc0 + bj * HALF;
                    if (pn == 22) {
                        if (bj == 0 && cc < 24) {
#pragma unroll
                            for (int e = 0; e < 4; ++e) { gates[(size_t)r * 24 + cc + e] = 1.f / (1.f + __expf(-v0[e])); gates[(size_t)r * 24 + cc + 4 + e] = 1.f / (1.f + __expf(-v1[e])); }
                        }
                    } else {
                        bf16_t* dst;
                        if (pn < 4) { v0 = v0 * qscale; v1 = v1 * qscale; dst = Q + (size_t)r * 1024 + pn * 256 + cc; }
                        else if (pn < 10) { const int b = r >> 12, t = r & 4095; dst = KV + (size_t)(pn - 4) * (4 * 4096 * 128) + ((size_t)((b * 2 + bj) * 4096 + t)) * 128 + cc0; }
                        else { const int idx = (pn - 10) >> 2; dst = C3 + (size_t)idx * (8192 * 1024) + (size_t)r * 1024 + ((pn - 10) & 3) * 256 + cc; }
                        u32x4 w; w.x = cvt_pk_bf16(v0[0], v0[1]); w.y = cvt_pk_bf16(v0[2], v0[3]); w.z = cvt_pk_bf16(v1[0], v1[1]); w.w = cvt_pk_bf16(v1[2], v1[3]);
                        *(u32x4*)dst = w;
                    } } }
    }
};
struct OneUnit {
    bool has; Unit u;
    __device__ __forceinline__ bool next(int i, Unit& o) const { if (i == 0 && has) { o = u; return true; } return false; }
    __device__ __forceinline__ void a_ready(const Unit&) const {}
    __device__ __forceinline__ void done(const Unit&) const {}
};

template <class Epi, class Sched, bool ALIGN_EPI = false, bool SP2 = false>
__device__ __forceinline__ void gemm_phase(PG8_LAS unsigned char* lds, const Gemm g, const Sched& S, const Epi& E) {
    const int tid = threadIdx.x, wid = __builtin_amdgcn_readfirstlane(tid >> 6), lane = tid & 63, wr = wid >> 2, wc = wid & 3, fr = lane & 15, fq = lane >> 4;
    const int K = g.K, nt = K / BK;
    unsigned voffA[2], voffB[2];
#pragma unroll
    for (int i = 0; i < 2; ++i) { int R, C; stage_rc(tid * 16 + i * 8192, R, C); const int Rb = Epi::PERM ? ((R & ~31) + perm32(R & 31)) : R;
        voffA[i] = (unsigned)(R * g.lda + C) * 2u; voffB[i] = (unsigned)(Rb * g.ldb + C) * 2u; }
    const size_t kstep = (size_t)(BK * 2);
    const size_t hstepA = (size_t)HALF * g.lda * 2, hstepB = (size_t)HALF * g.ldb * 2;
    const size_t tstepA = 2 * hstepA, tstepB = 2 * hstepB;
    const unsigned ldsw = (unsigned)wid * 1024u;
    const int aoff = lds_byte(wr * 64 + fr, fq * 8), boff = lds_byte(wc * 32 + fr, fq * 8);
#define PG8_SA(b, h) (((b) * 2 + (h)) * HTB)
#define PG8_SB(b, h) ((4 + (b) * 2 + (h)) * HTB)
#define PG8_STAGE(bufoff, gbase, voff) do { _Pragma("unroll") for (int _i = 0; _i < 2; ++_i) \
        __builtin_amdgcn_global_load_lds((const unsigned*)((const char*)(gbase) + (voff)[_i]), (PG8_LAS unsigned*)(lds + (bufoff) + ldsw + _i * 8192), 16, 0, 0); } while (0)
#define PG8_LDA(dst, b, h) do { _Pragma("unroll") for (int m = 0; m < 4; ++m) _Pragma("unroll") for (int k = 0; k < 2; ++k) dst[m][k] = *(const PG8_LAS bf16x8*)(lds + PG8_SA(b, h) + aoff + m * 2048 + k * 1024); } while (0)
#define PG8_LDB(dst, b, h) do { _Pragma("unroll") for (int n = 0; n < 2; ++n) _Pragma("unroll") for (int k = 0; k < 2; ++k) dst[n][k] = *(const PG8_LAS bf16x8*)(lds + PG8_SB(b, h) + boff + n * 2048 + k * 1024); } while (0)
#define PG8_MMA(ai, bj, At, Bt) do { __builtin_amdgcn_s_setprio(1); _Pragma("unroll") for (int m = 0; m < 4; ++m) _Pragma("unroll") for (int n = 0; n < 2; ++n) _Pragma("unroll") for (int k = 0; k < 2; ++k) \
        acc[ai][bj][m][n] = __builtin_amdgcn_mfma_f32_16x16x32_bf16(Bt[n][k], At[m][k], acc[ai][bj][m][n], 0, 0, 0); __builtin_amdgcn_s_setprio(0); } while (0)
#define PG8_WAIT_V(n) asm volatile("s_waitcnt vmcnt(" #n ")" ::: "memory")
#define PG8_WAIT_L(n) asm volatile("s_waitcnt lgkmcnt(" #n ")" ::: "memory")
#define PG8_BAR __builtin_amdgcn_s_barrier()
#define PG8_SCHED __builtin_amdgcn_sched_barrier(0)
    Unit cur, nxt; int ui = 0;
    if (!S.next(0, cur)) return;
    f32x4 acc[2][2][4][2];
#pragma unroll
    for (int a = 0; a < 2; ++a)
#pragma unroll
        for (int b = 0; b < 2; ++b)
#pragma unroll
            for (int m = 0; m < 4; ++m)
#pragma unroll
                for (int n = 0; n < 2; ++n) acc[a][b][m][n] = (f32x4){0.f, 0.f, 0.f, 0.f};
    bf16x8 At[4][2], B0[2][2], B1[2][2];
    const char* cA = (const char*)g.A + (size_t)cur.pm * tstepA; const char* cB = (const char*)g.Bt + (size_t)cur.pn * tstepB;
    S.a_ready(cur);
    if constexpr (SP2) {
        PG8_STAGE(PG8_SB(0, 0), cB, voffB); PG8_STAGE(PG8_SB(0, 1), cB + hstepB, voffB); PG8_STAGE(PG8_SA(0, 0), cA, voffA); PG8_STAGE(PG8_SA(0, 1), cA + hstepA, voffA);
        if (wr == 1) PG8_BAR;
        PG8_WAIT_V(2); PG8_BAR;
        PG8_STAGE(PG8_SB(1, 0), cB + kstep, voffB); PG8_STAGE(PG8_SA(1, 0), cA + kstep, voffA); PG8_STAGE(PG8_SB(1, 1), cB + hstepB + kstep, voffB);
        PG8_WAIT_V(6); PG8_BAR;
    } else {
        PG8_STAGE(PG8_SB(0, 0), cB, voffB); PG8_STAGE(PG8_SA(0, 0), cA, voffA); PG8_STAGE(PG8_SB(0, 1), cB + hstepB, voffB); PG8_STAGE(PG8_SA(0, 1), cA + hstepA, voffA);
        if (wr == 1) PG8_BAR;
        PG8_WAIT_V(4); PG8_BAR;
        PG8_STAGE(PG8_SB(1, 0), cB + kstep, voffB); PG8_STAGE(PG8_SA(1, 0), cA + kstep, voffA); PG8_STAGE(PG8_SB(1, 1), cB + hstepB + kstep, voffB);
        PG8_WAIT_V(6); PG8_BAR;
    }
    for (;;) {
        const bool has_next = S.next(ui + 1, nxt);
        const char* nA = has_next ? (const char*)g.A + (size_t)nxt.pm * tstepA : cA; const char* nB = has_next ? (const char*)g.Bt + (size_t)nxt.pn * tstepB : cB;
        for (int t = 0; t < nt; t += 2) {
            const bool last = (t == nt - 2);
            const char* a1 = cA + (size_t)(t + 1) * kstep;
            const char* a2 = last ? nA : cA + (size_t)(t + 2) * kstep; const char* b2 = last ? nB : cB + (size_t)(t + 2) * kstep;
            const char* a3 = a2 + kstep; const char* b3 = b2 + kstep;
            if (last && has_next) S.a_ready(nxt);
            if constexpr (SP2) {
            PG8_LDB(B0, 0, 0); PG8_LDB(B1, 0, 1); PG8_SCHED; PG8_LDA(At, 0, 0); PG8_STAGE(PG8_SA(1, 1), a1 + hstepA, voffA);
            PG8_WAIT_V(8); PG8_WAIT_L(0); PG8_BAR; PG8_MMA(0, 0, At, B0); PG8_MMA(0, 1, At, B1); PG8_BAR; PG8_SCHED;
            PG8_LDA(At, 0, 1); PG8_STAGE(PG8_SB(0, 0), b2, voffB); PG8_STAGE(PG8_SB(0, 1), b2 + hstepB, voffB); PG8_STAGE(PG8_SA(0, 0), a2, voffA);
            PG8_WAIT_V(8); PG8_WAIT_L(0); PG8_BAR; PG8_MMA(1, 0, At, B0); PG8_MMA(1, 1, At, B1); PG8_BAR; PG8_SCHED;
            PG8_LDB(B0, 1, 0); PG8_LDB(B1, 1, 1); PG8_SCHED; PG8_LDA(At, 1, 0); PG8_STAGE(PG8_SA(0, 1), a2 + hstepA, voffA);
            PG8_WAIT_V(8); PG8_WAIT_L(0); PG8_BAR; PG8_MMA(0, 0, At, B0); PG8_MMA(0, 1, At, B1); PG8_BAR; PG8_SCHED;
            PG8_LDA(At, 1, 1); PG8_STAGE(PG8_SB(1, 0), b3, voffB); PG8_STAGE(PG8_SB(1, 1), b3 + hstepB, voffB); PG8_STAGE(PG8_SA(1, 0), a3, voffA);
            PG8_WAIT_V(8); PG8_WAIT_L(0); PG8_BAR; PG8_MMA(1, 0, At, B0); PG8_MMA(1, 1, At, B1); PG8_BAR; PG8_SCHED;
            } else {
            PG8_LDB(B0, 0, 0); PG8_SCHED; PG8_LDA(At, 0, 0); PG8_STAGE(PG8_SA(1, 1), a1 + hstepA, voffA);
            PG8_WAIT_L(8); PG8_BAR; PG8_WAIT_L(0); PG8_MMA(0, 0, At, B0); PG8_BAR; PG8_SCHED;
            PG8_LDB(B1, 0, 1); PG8_STAGE(PG8_SB(0, 0), b2, voffB);
            PG8_BAR; PG8_WAIT_L(0); PG8_MMA(0, 1, At, B1); PG8_BAR;
            PG8_LDA(At, 0, 1); PG8_STAGE(PG8_SA(0, 0), a2, voffA);
            PG8_BAR; PG8_WAIT_L(0); PG8_MMA(1, 0, At, B0); PG8_BAR; PG8_SCHED;
            PG8_STAGE(PG8_SB(0, 1), b2 + hstepB, voffB);
            PG8_WAIT_V(6); PG8_BAR; PG8_MMA(1, 1, At, B1); PG8_BAR;
            PG8_LDB(B0, 1, 0); PG8_SCHED; PG8_LDA(At, 1, 0); PG8_STAGE(PG8_SA(0, 1), a2 + hstepA, voffA);
            PG8_WAIT_L(8); PG8_BAR; PG8_WAIT_L(0); PG8_MMA(0, 0, At, B0); PG8_BAR; PG8_SCHED;
            PG8_LDB(B1, 1, 1); PG8_STAGE(PG8_SB(1, 0), b3, voffB);
            PG8_BAR; PG8_WAIT_L(0); PG8_MMA(0, 1, At, B1); PG8_BAR;
            PG8_LDA(At, 1, 1); PG8_STAGE(PG8_SA(1, 0), a3, voffA);
            PG8_BAR; PG8_WAIT_L(0); PG8_MMA(1, 0, At, B0); PG8_BAR; PG8_SCHED;
            PG8_STAGE(PG8_SB(1, 1), b3 + hstepB, voffB);
            PG8_WAIT_V(6); PG8_BAR; PG8_MMA(1, 1, At, B1); PG8_BAR;
            }
        }
        if constexpr (ALIGN_EPI) { if (wr == 0) PG8_BAR; }
        if constexpr (!Epi::AFTER_DRAIN) { E(acc, cur, wr, wc, fr, fq); S.done(cur); }
        if (!has_next) break;
#pragma unroll
        for (int a = 0; a < 2; ++a)
#pragma unroll
            for (int b = 0; b < 2; ++b)
#pragma unroll
                for (int m = 0; m < 4; ++m)
#pragma unroll
                    for (int n = 0; n < 2; ++n) acc[a][b][m][n] = (f32x4){0.f, 0.f, 0.f, 0.f};
        cur = nxt; cA = nA; cB = nB; ++ui;
        if constexpr (ALIGN_EPI) { if (wr == 1) PG8_BAR; }
    }
    PG8_WAIT_V(0);
    if constexpr (!ALIGN_EPI) { if (wr == 0) PG8_BAR; }
    PG8_BAR;
    if constexpr (Epi::AFTER_DRAIN) { E.fused(acc, cur, wr, wc, fr, fq, lds, wid, lane); S.done(cur); }
#undef PG8_SA
#undef PG8_SB
#undef PG8_STAGE
#undef PG8_LDA
#undef PG8_LDB
#undef PG8_MMA
#undef PG8_WAIT_V
#undef PG8_WAIT_L
#undef PG8_BAR
#undef PG8_SCHED
}
}
#define GAS __attribute__((address_space(1)))
#define LAS __attribute__((address_space(3)))
typedef unsigned short bf16;
typedef unsigned v4u __attribute__((ext_vector_type(4)));
typedef float f32x4 __attribute__((ext_vector_type(4)));
typedef short bf16x8 __attribute__((ext_vector_type(8)));
typedef GAS unsigned gu32;
typedef GAS unsigned long long gu64;
#define RLX_AGENT __ATOMIC_RELAXED, __HIP_MEMORY_SCOPE_AGENT
#define LDS_WAIT() asm volatile("s_waitcnt lgkmcnt(0)" ::: "memory")
#define VM_WAIT() asm volatile("s_waitcnt vmcnt(0)" ::: "memory")
__device__ __forceinline__ unsigned long long rt() { return __builtin_amdgcn_s_memrealtime(); }
__device__ __forceinline__ unsigned f2bf(float f) { unsigned u = __builtin_bit_cast(unsigned, f); return (u + 0x7fffu + ((u >> 16) & 1u)) >> 16; }
__device__ __forceinline__ unsigned pk2(float lo, float hi) { return f2bf(lo) | (f2bf(hi) << 16); }

#define XB_TMO      128
#define XB_XCNT(j)  (256  + 64 * (j))
#define XB_XSUB(j)  (1280 + 64 * (j))
#define XB_XGEN(j)  (2304 + 64 * (j))
#define XB_TOP      3328
#define XB_TOPGEN   3392
#define XCD_BAR_WORDS 3456
#define XB_SPIN_CAP (1u << 18)

__device__ __forceinline__ unsigned xb_ld(unsigned* p)              { return __hip_atomic_load(p, __ATOMIC_RELAXED, __HIP_MEMORY_SCOPE_AGENT); }
__device__ __forceinline__ unsigned xb_add(unsigned* p, unsigned v) { return __hip_atomic_fetch_add(p, v, __ATOMIC_RELAXED, __HIP_MEMORY_SCOPE_AGENT); }
__device__ __forceinline__ unsigned xb_xcc_id() { return (unsigned)__builtin_amdgcn_s_getreg((3 << 11) | 20) & 0xFu; }
#define XB_SPIN(cond, bar) do { unsigned _sp = 0; while (cond) { __builtin_amdgcn_s_sleep(1); \
    if ((++_sp & 255u) == 0u) { if (xb_ld(&(bar)[XB_TMO])) break; if (_sp > XB_SPIN_CAP) { atomicAdd(&(bar)[XB_TMO], 1u); break; } } } } while (0)

struct XcdBarrier {
    unsigned* bar; unsigned x;
    volatile LAS unsigned* st;
};

__device__ __forceinline__ XcdBarrier xcd_barrier_post(unsigned* bar, volatile LAS unsigned* st) {
    XcdBarrier b; b.bar = bar; b.x = xb_xcc_id(); b.st = st;
    if (threadIdx.x == 0) (void)xb_add(&bar[XB_XCNT(b.x)], 1u);
    return b;
}
__device__ __forceinline__ void xcd_barrier_complete(unsigned* bar, unsigned x, unsigned& nloc, unsigned& nx) {
    const unsigned G = gridDim.x * gridDim.y * gridDim.z;
    unsigned sum, cnt, mine, sp = 0u;
    for (;;) {
        sum = 0u; cnt = 0u; mine = 0u;
#pragma unroll
        for (unsigned j = 0; j < 16; ++j) { const unsigned c = xb_ld(&bar[XB_XCNT(j)]); sum += c; cnt += (c > 0u) ? 1u : 0u; mine = (j == x) ? c : mine; }
        if (sum == G) break;
        __builtin_amdgcn_s_sleep(1);
        if ((++sp & 255u) == 0u) { if (xb_ld(&bar[XB_TMO])) break; if (sp > XB_SPIN_CAP) { atomicAdd(&bar[XB_TMO], 1u); break; } }
    }
    nloc = mine > 0u ? mine : 1u; nx = cnt > 0u ? cnt : 1u;
}

__device__ __forceinline__ void xcd_barrier(const XcdBarrier& b) {
    asm volatile("s_waitcnt vmcnt(0)" ::: "memory");
    __syncthreads();
    if (threadIdx.x == 0) {
        unsigned* bar = b.bar;
        __builtin_amdgcn_s_waitcnt(0);
        unsigned nloc = b.st[0], nx = b.st[1];
        if (nloc == 0u) { xcd_barrier_complete(bar, b.x, nloc, nx); b.st[0] = nloc; b.st[1] = nx; }
        const unsigned old = xb_add(&bar[XB_XSUB(b.x)], 1u);
        const unsigned gen = old / nloc;
        if (old + 1u == (gen + 1u) * nloc) {
            __builtin_amdgcn_fence(__ATOMIC_RELEASE, "agent");
            asm volatile("s_waitcnt vmcnt(0)" ::: "memory");
            const unsigned og = xb_add(&bar[XB_TOP], 1u);
            const unsigned tg = og / nx;
            if (og + 1u == (tg + 1u) * nx) xb_add(&bar[XB_TOPGEN], 1u);
            else XB_SPIN(xb_ld(&bar[XB_TOPGEN]) == tg, bar);
            __builtin_amdgcn_fence(__ATOMIC_ACQUIRE, "agent");
            xb_add(&bar[XB_XGEN(b.x)], 1u);
            asm volatile("s_waitcnt vmcnt(0)" ::: "memory");
        } else {
            XB_SPIN(xb_ld(&bar[XB_XGEN(b.x)]) == gen, bar);
            __builtin_amdgcn_fence(__ATOMIC_ACQUIRE, "agent");
            asm volatile("s_waitcnt vmcnt(0)" ::: "memory");
        }
    }
    __syncthreads();
}
constexpr int NWAVES = 8;
constexpr int B_ = 2, T_ = 4096, D_ = 2048, M_ = B_ * T_;
constexpr int NKV = 2, HD = 128, NCMP = 255, NSEL = 64, TOPK = 16, WIN = 512;
constexpr int DFF = 8192, INW = 5656, NQT = 5888;
constexpr float EPS = 1e-6f, NEGV = -1e30f, FORCEV = 1e9f;
constexpr float LOG2E = 1.4426950408889634f;
constexpr float QSCALE = 0.08838834764831845f * 1.4426950408889634f;

constexpr size_t MiB = 1u << 20;
constexpr size_t WS_CTL = 0, CTL_ZERO_BYTES = 65536;
constexpr size_t WS_PEB = 1 * MiB;
constexpr size_t WS_SELM = 1 * MiB + 128 * 1024;
constexpr size_t WS_KCMP = 1 * MiB + 256 * 1024;
constexpr size_t WS_VCMP = 1 * MiB + 512 * 1024;
constexpr size_t WS_GATES = 2 * MiB;
constexpr size_t WS_WDN = 4 * MiB, WS_WUP = 36 * MiB;
constexpr size_t WS_H = 68 * MiB;
constexpr size_t WS_F = 36 * MiB;
constexpr size_t WS_U = 100 * MiB;
constexpr size_t WS_WIN = 100 * MiB;
constexpr size_t WS_SLAB = 100 * MiB;
constexpr size_t WS_WO = 124 * MiB;
constexpr size_t WS_W1 = 132 * MiB;
constexpr size_t WS_Q = 136 * MiB;
constexpr size_t WS_KV = 152 * MiB;
constexpr size_t WS_C3 = 176 * MiB;
constexpr size_t WS_OC = 228 * MiB, WS_OW = 244 * MiB;
constexpr size_t WS_END = 260 * MiB;
constexpr size_t KVSZ = (size_t)4 * 4096 * 128;

constexpr int RING_BYTES = 131072;
constexpr int LDSCTL_OFF = RING_BYTES, MISC_OFF = LDSCTL_OFF + 320;
constexpr int LDS_BYTES = 147456;

__device__ __constant__ unsigned char BUCKET_TAB[128] = {
  0, 1, 2, 3, 4, 5, 6, 7, 8, 9, 10, 11, 12, 13, 14, 15, 16, 16, 16, 17, 17, 18, 18, 18, 19, 19, 19, 20, 20, 20, 20, 21, 21, 21, 21, 22, 22, 22, 22, 22,
  23, 23, 23, 23, 23, 23, 24, 24, 24, 24, 24, 24, 25, 25, 25, 25, 25, 25, 25, 26, 26, 26, 26, 26, 26, 26, 26, 27, 27, 27, 27, 27, 27, 27, 27, 27, 27,
  28, 28, 28, 28, 28, 28, 28, 28, 28, 28, 29, 29, 29, 29, 29, 29, 29, 29, 29, 29, 29, 29, 30, 30, 30, 30, 30, 30, 30, 30, 30, 30, 30, 30, 30, 30,
  31, 31, 31, 31, 31, 31, 31, 31, 31, 31, 31, 31, 31, 31, 31};
__device__ __forceinline__ int rel_bucket(int dist) { int n = dist < 0 ? 0 : dist; return n >= 113 ? 31 : (int)BUCKET_TAB[n]; }
__device__ __forceinline__ float bf2f(unsigned short v) { return __builtin_bit_cast(float, (unsigned)v << 16); }

__device__ __forceinline__ float wave_sum(float v) {
#pragma unroll
    for (int o = 1; o < 64; o <<= 1) v += __shfl_xor(v, o);
    return v;
}

__device__ __forceinline__ int win_src_col(int n) { return n < 2560 ? n : (n < 5632 ? n + 24 : (n < 5656 ? n - 5632 + 2560 : -1)); }
__device__ __forceinline__ void p0_transpose_item(const float* W, int ldw, int K, int nblk, bf16* WT, LAS float* scr, int item, int lane, bool remap) {
    const int kb = item / nblk, nb = item % nblk, k0 = 64 * kb, n0 = 32 * nb;
    const int nn = n0 + (lane & 31); const int sc = remap ? win_src_col(nn) : nn;
#pragma unroll 8
    for (int i = 0; i < 32; ++i) { const int kk = 2 * i + (lane >> 5); scr[kk * 33 + (lane & 31)] = sc >= 0 ? W[(size_t)(k0 + kk) * ldw + sc] : 0.f; }
    LDS_WAIT(); asm volatile("" ::: "memory");
    const int c = lane & 7;
#pragma unroll
    for (int j = 0; j < 4; ++j) { const int n = (lane >> 3) + 8 * j; const LAS float* s = scr + (8 * c) * 33 + n;
        v4u o; o.x = pk2(s[0 * 33], s[1 * 33]); o.y = pk2(s[2 * 33], s[3 * 33]); o.z = pk2(s[4 * 33], s[5 * 33]); o.w = pk2(s[6 * 33], s[7 * 33]);
        *(GAS v4u*)(WT + (size_t)(n0 + n) * K + k0 + 8 * c) = o; }
    LDS_WAIT(); asm volatile("" ::: "memory");
}
__device__ __forceinline__ void rms_row_to_bf16(const float* xrow, const float* gain, bf16* orow, int lane) {
    const GAS f32x4* xr = (const GAS f32x4*)xrow + lane; const GAS f32x4* gr = (const GAS f32x4*)gain + lane;
    f32x4 v[8]; float s = 0.f;
#pragma unroll
    for (int j = 0; j < 8; ++j) { v[j] = xr[64 * j]; s += (v[j].x * v[j].x + v[j].y * v[j].y) + (v[j].z * v[j].z + v[j].w * v[j].w); }
    const float r = rsqrtf(wave_sum(s) * (1.f / D_) + EPS);
    GAS unsigned long long* o8 = (GAS unsigned long long*)orow + lane;
#pragma unroll
    for (int j = 0; j < 8; ++j) { const f32x4 g = gr[64 * j];
        o8[64 * j] = (unsigned long long)pk2((v[j].x * r) * g.x, (v[j].y * r) * g.y) | ((unsigned long long)pk2((v[j].z * r) * g.z, (v[j].w * r) * g.w) << 32); }
}

struct Args { const float* in[16]; float* out; unsigned char* ws; int ph_lo, ph_hi, li, pad; };

__global__ void __launch_bounds__(NWAVES * 64, 2) mega_fwd(Args args) {
    extern __shared__ __attribute__((aligned(16))) unsigned char lds_raw[];
    LAS unsigned char* lds = (LAS unsigned char*)lds_raw;
    volatile LAS unsigned* MISC = (volatile LAS unsigned*)(lds + MISC_OFF);
    const int tid = threadIdx.x, lane = tid & 63, wave = __builtin_amdgcn_readfirstlane(tid >> 6);
    const int G = gridDim.x; const int bx = blockIdx.x;
    const int vcu = (G % 8 == 0) ? (bx % 8) * (G / 8) + bx / 8 : bx;
    unsigned char* ws = args.ws;
    const float* x = args.in[0]; const float* w_in = args.in[1]; const float* pe = args.in[2];
    const float* wk1 = args.in[3]; const float* wk2 = args.in[4]; const float* wv1 = args.in[5]; const float* wv2 = args.in[6];
    const float* conv_w = args.in[7]; const float* w_o = args.in[9]; const float* w_up = args.in[10]; const float* w_down = args.in[11];
    const float* g_pre_mix = args.in[12]; const float* g_post_mix = args.in[13]; const float* g_pre_ffn = args.in[14]; const float* g_post_ffn = args.in[15];
    float* out = args.out;
    bf16* WinT = (bf16*)(ws + WS_WIN); bf16* WoT = (bf16*)(ws + WS_WO); bf16* WupT = (bf16*)(ws + WS_WUP); bf16* WdnT = (bf16*)(ws + WS_WDN);
    bf16* W1T = (bf16*)(ws + WS_W1); bf16* Hb = (bf16*)(ws + WS_H); bf16* Qb = (bf16*)(ws + WS_Q); bf16* KVb = (bf16*)(ws + WS_KV);
    bf16* C3b = (bf16*)(ws + WS_C3); bf16* Ub = (bf16*)(ws + WS_U); float* Fb = (float*)(ws + WS_F); float* SLAB = (float*)(ws + WS_SLAB);
    float* PEB = (float*)(ws + WS_PEB); float* GATES = (float*)(ws + WS_GATES); bf16* KCMP = (bf16*)(ws + WS_KCMP); bf16* VCMP = (bf16*)(ws + WS_VCMP);

    for (int u = tid; u < (LDS_BYTES - LDSCTL_OFF) / 4; u += NWAVES * 64) ((LAS unsigned*)(lds + LDSCTL_OFF))[u] = 0u;
    __syncthreads();
    XcdBarrier bar = xcd_barrier_post((unsigned*)(ws + WS_CTL) + 1024 + args.li * 4096, MISC + 8);
    const int lo = args.ph_lo, hi = args.ph_hi;
#define IN(k) (lo <= (k) && (k) < hi)
#define BOTH(k) (IN(k) && IN((k) + 1))
    const int gw = vcu * NWAVES + wave, NGW = G * NWAVES;

    if (IN(0)) {
        LAS float* scr = (LAS float*)(lds + wave * 16384);
        constexpr int I_IN = 32 * (NQT / 32), I_O = 32 * 64, I_UP = 32 * 256, I_DN = 128 * 64, I_C1 = 64 * 8;
        constexpr int NITEMS = I_IN + I_O + I_UP + I_DN + 2 * I_C1;
        for (int it = gw; it < NITEMS; it += NGW) {
            int r = it;
            if (r < I_IN) { p0_transpose_item(w_in, INW, D_, NQT / 32, WinT, scr, r, lane, true); continue; } r -= I_IN;
            if (r < I_O) { p0_transpose_item(w_o, D_, 2048, 64, WoT, scr, r, lane, false); continue; } r -= I_O;
            if (r < I_UP) { p0_transpose_item(w_up, DFF, D_, 256, WupT, scr, r, lane, false); continue; } r -= I_UP;
            if (r < I_DN) { p0_transpose_item(w_down, D_, DFF, 64, WdnT, scr, r, lane, false); continue; } r -= I_DN;
            if (r < I_C1) { p0_transpose_item(wk1, 256, 4096, 8, W1T, scr, r, lane, false); continue; } r -= I_C1;
            p0_transpose_item(wv1, 256, 4096, 8, W1T + (size_t)256 * 4096, scr, r, lane, false);
        }
        for (int m = gw; m < M_; m += NGW) rms_row_to_bf16(x + (size_t)m * D_, g_pre_mix, Hb + (size_t)m * D_, lane);
        for (int it = gw; it < 256; it += NGW) {
            const int kv = it >> 7, ch = (it >> 2) & 31, hg = it & 3; const float* w1 = kv ? wv1 : wk1;
            float s = 0.f;
            for (int k = ch * 128; k < ch * 128 + 128; ++k) s += pe[k] * w1[(size_t)k * 256 + hg * 64 + lane];
            PEB[(kv * 32 + ch) * 256 + hg * 64 + lane] = s;
        }
        if (BOTH(0)) xcd_barrier(bar);
    }

    if (IN(1)) {
        pg8::Gemm g{Hb, WinT, M_, NQT, D_, D_, D_}; pg8::StaticOrder S; S.init(M_, NQT, G, bx);
        pg8::EpiInProj E{Qb, KVb, C3b, GATES, QSCALE};
        pg8::gemm_phase<pg8::EpiInProj, pg8::StaticOrder, true, true>(lds, g, S, E);
        if (BOTH(1)) xcd_barrier(bar);
    }

    if (IN(2)) {
        {
            const bool has = vcu < 64; const int kv = (vcu >> 5) & 1, ch = (vcu >> 2) & 7, pm = vcu & 3;
            pg8::Gemm g{KVb + (size_t)kv * KVSZ + ch * 512, W1T + (size_t)kv * 256 * 4096 + ch * 512, 1024, 256, 512, 2048, 4096};
            pg8::OneUnit S{has, {pm, 0}};
            pg8::EpiF32 E{SLAB + (size_t)(kv * 8 + ch) * 1024 * 256, 256};
            pg8::gemm_phase<pg8::EpiF32, pg8::OneUnit, false, true>(lds, g, S, E);
        }
        {
            const bf16* CH = C3b; const bf16* CB = C3b + (size_t)M_ * 1024; const bf16* CC = C3b + (size_t)2 * M_ * 1024;
            for (int idx = vcu * 512 + tid; idx < M_ * 128; idx += G * 512) {
                const int r = idx >> 7, c8 = (idx & 127) * 8, t = r & 4095; const size_t o = (size_t)r * 1024 + c8;
                const v4u h2 = *(const GAS v4u*)(CH + o), c2 = *(const GAS v4u*)(CC + o), bb = *(const GAS v4u*)(CB + o);
                v4u h1 = {0, 0, 0, 0}, c1 = {0, 0, 0, 0}, h0 = {0, 0, 0, 0}, c0 = {0, 0, 0, 0};
                if (t >= 1) { h1 = *(const GAS v4u*)(CH + o - 1024); c1 = *(const GAS v4u*)(CC + o - 1024); }
                if (t >= 2) { h0 = *(const GAS v4u*)(CH + o - 2048); c0 = *(const GAS v4u*)(CC + o - 2048); }
                unsigned ow[4];
#pragma unroll
                for (int e = 0; e < 4; ++e) {
                    float res[2];
#pragma unroll
                    for (int p = 0; p < 2; ++p) {
                        const int sh = 16 * p; const int col = c8 + 2 * e + p;
                        const float u2 = bf2f((unsigned short)(c2[e] >> sh)) * bf2f((unsigned short)(h2[e] >> sh));
                        const float u1 = bf2f((unsigned short)(c1[e] >> sh)) * bf2f((unsigned short)(h1[e] >> sh));
                        const float u0 = bf2f((unsigned short)(c0[e] >> sh)) * bf2f((unsigned short)(h0[e] >> sh));
                        float y = conv_w[col] * u0; y = y + conv_w[1024 + col] * u1; y = y + conv_w[2048 + col] * u2;
                        res[p] = bf2f((unsigned short)(bb[e] >> sh)) * y;
                    }
                    ow[e] = pk2(res[0], res[1]);
                }
                v4u ov; ov.x = ow[0]; ov.y = ow[1]; ov.z = ow[2]; ov.w = ow[3];
                *(GAS v4u*)(Hb + (size_t)r * 2048 + 1024 + c8) = ov;
            }
        }
        if (BOTH(2)) xcd_barrier(bar);
    }

    if (IN(3)) {
        LAS float* hid = (LAS float*)lds;
        for (int it = vcu; it < 64; it += G) {
            const int kv = it >> 5, bg = (it >> 3) & 3, sl = it & 7, r0 = bg * 256 + sl * 32;
            const float* w2 = kv ? wv2 : wk2; bf16* outp = kv ? VCMP : KCMP;
            {
                const int h = tid & 255; float pb = 0.f;
                for (int c2 = 0; c2 < 32; ++c2) pb += PEB[(kv * 32 + c2) * 256 + h];
                for (int e = tid; e < 32 * 256; e += 512) { const int r = e >> 8; float s = 0.f;
                    for (int ch = 0; ch < 8; ++ch) s += SLAB[((size_t)(kv * 8 + ch) * 1024 + r0 + r) * 256 + h];
                    s += pb; hid[e] = s / (1.f + __expf(-s)); }
            }
            __syncthreads();
            {
                const int e = tid & 127, rg = tid >> 7; float acc[8];
#pragma unroll
                for (int i = 0; i < 8; ++i) acc[i] = 0.f;
                for (int h = 0; h < 256; ++h) { const float w = w2[h * 128 + e];
#pragma unroll
                    for (int i = 0; i < 8; ++i) acc[i] += hid[(rg * 8 + i) * 256 + h] * w; }
#pragma unroll
                for (int i = 0; i < 8; ++i) { const int c = sl * 32 + rg * 8 + i; outp[((size_t)bg * 256 + c) * 128 + e] = (c < NCMP) ? (bf16)f2bf(acc[i]) : (bf16)0; }
            }
            __syncthreads();
        }
        if (BOTH(3)) xcd_barrier(bar);
    }


    if (IN(6)) {
        pg8::Gemm g{Hb, WoT, M_, D_, 2048, 2048, 2048}; pg8::StaticOrder S; S.init(M_, D_, G, bx);
        pg8::EpiF32 E{out, D_};
        pg8::gemm_phase<pg8::EpiF32, pg8::StaticOrder, true, true>(lds, g, S, E);
        if (BOTH(6)) xcd_barrier(bar);
    }

    if (IN(7)) {
        for (int m = gw; m < M_; m += NGW) {
            GAS f32x4* mr = (GAS f32x4*)(out + (size_t)m * D_) + lane; const GAS f32x4* xr = (const GAS f32x4*)(x + (size_t)m * D_) + lane;
            const GAS f32x4* g1 = (const GAS f32x4*)g_post_mix + lane; const GAS f32x4* g2 = (const GAS f32x4*)g_pre_ffn + lane;
            f32x4 v[8]; float s = 0.f;
#pragma unroll
            for (int j = 0; j < 8; ++j) { v[j] = mr[64 * j]; s += (v[j].x * v[j].x + v[j].y * v[j].y) + (v[j].z * v[j].z + v[j].w * v[j].w); }
            const float r1 = rsqrtf(wave_sum(s) * (1.f / D_) + EPS); float s2 = 0.f;
#pragma unroll
            for (int j = 0; j < 8; ++j) { const f32x4 g = g1[64 * j], xx = xr[64 * j];
                v[j].x = xx.x + (v[j].x * r1) * g.x; v[j].y = xx.y + (v[j].y * r1) * g.y; v[j].z = xx.z + (v[j].z * r1) * g.z; v[j].w = xx.w + (v[j].w * r1) * g.w;
                mr[64 * j] = v[j]; s2 += (v[j].x * v[j].x + v[j].y * v[j].y) + (v[j].z * v[j].z + v[j].w * v[j].w); }
            const float r2 = rsqrtf(wave_sum(s2) * (1.f / D_) + EPS);
            GAS unsigned long long* o8 = (GAS unsigned long long*)(Hb + (size_t)m * D_) + lane;
#pragma unroll
            for (int j = 0; j < 8; ++j) { const f32x4 g = g2[64 * j];
                o8[64 * j] = (unsigned long long)pk2((v[j].x * r2) * g.x, (v[j].y * r2) * g.y) | ((unsigned long long)pk2((v[j].z * r2) * g.z, (v[j].w * r2) * g.w) << 32); }
        }
        if (BOTH(7)) xcd_barrier(bar);
    }

    if (IN(8)) {
        pg8::Gemm g{Hb, WupT, M_, DFF, D_, D_, D_}; pg8::StaticOrder S; S.init(M_, DFF, G, bx);
        pg8::EpiRelu2Bf16 E{Ub, DFF};
        pg8::gemm_phase<pg8::EpiRelu2Bf16, pg8::StaticOrder, true, true>(lds, g, S, E);
        if (BOTH(8)) xcd_barrier(bar);
    }

    if (IN(9)) {
        pg8::Gemm g{Ub, WdnT, M_, D_, DFF, DFF, DFF}; pg8::StaticOrder S; S.init(M_, D_, G, bx);
        pg8::EpiF32 E{Fb, D_};
        pg8::gemm_phase<pg8::EpiF32, pg8::StaticOrder, true, true>(lds, g, S, E);
        if (BOTH(9)) xcd_barrier(bar);
    }

    if (IN(10)) {
        for (int m = gw; m < M_; m += NGW) {
            const GAS f32x4* fr = (const GAS f32x4*)(Fb + (size_t)m * D_) + lane; GAS f32x4* orow = (GAS f32x4*)(out + (size_t)m * D_) + lane;
            const GAS f32x4* g1 = (const GAS f32x4*)g_post_ffn + lane;
            f32x4 v[8]; float s = 0.f;
#pragma unroll
            for (int j = 0; j < 8; ++j) { v[j] = fr[64 * j]; s += (v[j].x * v[j].x + v[j].y * v[j].y) + (v[j].z * v[j].z + v[j].w * v[j].w); }
            const float r1 = rsqrtf(wave_sum(s) * (1.f / D_) + EPS);
#pragma unroll
            for (int j = 0; j < 8; ++j) { const f32x4 g = g1[64 * j]; f32x4 xx = orow[64 * j];
                xx.x = xx.x + (v[j].x * r1) * g.x; xx.y = xx.y + (v[j].y * r1) * g.y; xx.z = xx.z + (v[j].z * r1) * g.z; xx.w = xx.w + (v[j].w * r1) * g.w;
                orow[64 * j] = xx; }
        }
    }
#undef IN
#undef BOTH
}

__device__ __forceinline__ float block_max(float v, float* red) {
  for (int o = 32; o > 0; o >>= 1) v = fmaxf(v, __shfl_xor(v, o));
  __syncthreads();
  if ((threadIdx.x & 63) == 0) red[threadIdx.x >> 6] = v;
  __syncthreads();
  return fmaxf(fmaxf(red[0], red[1]), fmaxf(red[2], red[3]));
}
__device__ __forceinline__ float block_sum(float v, float* red) {
  for (int o = 32; o > 0; o >>= 1) v += __shfl_xor(v, o);
  __syncthreads();
  if ((threadIdx.x & 63) == 0) red[threadIdx.x >> 6] = v;
  __syncthreads();
  return (red[0] + red[1]) + (red[2] + red[3]);
}
__global__ __launch_bounds__(256) void cmp_attn_ref(const bf16* Qb, const bf16* KCMP, const bf16* VCMP, const float* rel_bias, bf16* OC, unsigned long long* selmask) {
  const int id = blockIdx.x, t = id % T_, g = (id / T_) % NKV, b = id / (T_ * NKV);
  const int tid = threadIdx.x;
  const size_t row = (size_t)b * T_ + t;
  __shared__ float q[4][HD];
  __shared__ float p[4][256];
  __shared__ float red[4];
  for (int i = tid; i < 512; i += 256) q[i >> 7][i & 127] = bf2f(Qb[row * 1024 + (g * 4 + (i >> 7)) * HD + (i & 127)]);
  __syncthreads();
  const int c = tid;
  const bool valid = (c < NCMP) && (16 * c + 31 <= t);
  float s[4] = {NEGV, NEGV, NEGV, NEGV};
  if (valid) {
    const int bk = rel_bucket(t - (16 * c + 31));
    const bf16* kr = KCMP + ((size_t)(b * NKV + g) * 256 + c) * HD;
    float a0 = 0.f, a1 = 0.f, a2 = 0.f, a3 = 0.f;
    for (int d = 0; d < HD; ++d) { const float kvv = bf2f(kr[d]); a0 += q[0][d] * kvv; a1 += q[1][d] * kvv; a2 += q[2][d] * kvv; a3 += q[3][d] * kvv; }
    s[0] = a0 + rel_bias[(g * 4 + 0) * 32 + bk] * LOG2E;
    s[1] = a1 + rel_bias[(g * 4 + 1) * 32 + bk] * LOG2E;
    s[2] = a2 + rel_bias[(g * 4 + 2) * 32 + bk] * LOG2E;
    s[3] = a3 + rel_bias[(g * 4 + 3) * 32 + bk] * LOG2E;
  }
#pragma unroll
  for (int h = 0; h < 4; ++h) {
    const float m = block_max(s[h], red);
    const float e = valid ? exp2f(s[h] - m) : 0.f;
    const float l = block_sum(e, red);
    p[h][c] = valid ? e / l : 0.f;
  }
  __syncthreads();
  {
    const int d = tid & 127, hp = tid >> 7;
    const bf16* vb = VCMP + (size_t)(b * NKV + g) * 256 * HD;
    float o0 = 0.f, o1 = 0.f;
    for (int cc = 0; cc < NCMP; ++cc) { const float vv = bf2f(vb[cc * HD + d]); o0 += p[hp * 2][cc] * vv; o1 += p[hp * 2 + 1][cc] * vv; }
    const int h0 = g * 4 + hp * 2;
    OC[row * 1024 + h0 * HD + d] = (bf16)f2bf(o0);
    OC[row * 1024 + (h0 + 1) * HD + d] = (bf16)f2bf(o1);
  }
  if (tid < 64) {
    const int j = tid, cur = t >> 6;
    float v = 0.f;
    for (int h = 0; h < 4; ++h)
      for (int cc = 4 * j - 1; cc <= 4 * j + 3; ++cc)
        if (cc >= 0 && cc < NCMP) v += p[h][cc];
    if (j == 0 || j == cur || j == cur - 1) v = FORCEV;
    if (j * 64 > t) v = NEGV;
    int rank = 0;
    for (int i = 0; i < 64; ++i) { const float vi = __shfl(v, i); rank += (vi > v || (vi == v && i < j)) ? 1 : 0; }
    const unsigned long long mk = __ballot(rank < TOPK);
    if (tid == 0) selmask[(size_t)(b * NKV + g) * T_ + t] = mk;
  }
}
template <int MODE>
__global__ __launch_bounds__(256) void attn_ref(const bf16* Qb, const bf16* KVb, const float* rel_bias, const unsigned long long* selmask, const float* GATES,
                                                const bf16* OC, bf16* OW, bf16* AO) {
  const int id = blockIdx.x, t = id % T_, g = (id / T_) % NKV, b = id / (T_ * NKV);
  const int tid = threadIdx.x;
  const size_t row = (size_t)b * T_ + t;
  __shared__ float q[4][HD];
  __shared__ float sc[4][1024];
  __shared__ float red[4];
  __shared__ int blist[16];
  __shared__ int nblk;
  const bf16* Kb = KVb + (size_t)(MODE ? 4 : 2) * KVSZ + (size_t)(b * NKV + g) * T_ * HD;
  const bf16* Vb = KVb + (size_t)(MODE ? 5 : 3) * KVSZ + (size_t)(b * NKV + g) * T_ * HD;
  for (int i = tid; i < 512; i += 256) q[i >> 7][i & 127] = bf2f(Qb[row * 1024 + (g * 4 + (i >> 7)) * HD + (i & 127)]);
  if (MODE == 0 && tid == 0) {
    const unsigned long long mk = selmask[(size_t)(b * NKV + g) * T_ + t];
    int n = 0;
    for (int j = 0; j < NSEL; ++j) if (((mk >> j) & 1ull) && j * 64 <= t && n < 16) blist[n++] = j;
    nblk = n;
  }
  __syncthreads();
  const int kstart = t - (WIN - 1) < 0 ? 0 : t - (WIN - 1);
  const int nkeys = MODE ? (t - kstart + 1) : nblk * 64;
  for (int i = tid; i < nkeys; i += 256) {
    const int pos = MODE ? (kstart + i) : (blist[i >> 6] * 64 + (i & 63));
    const bool valid = pos <= t;
    float s0 = NEGV, s1 = NEGV, s2 = NEGV, s3 = NEGV;
    if (valid) {
      const bf16* kr = Kb + (size_t)pos * HD;
      float a0 = 0.f, a1 = 0.f, a2 = 0.f, a3 = 0.f;
      for (int d = 0; d < HD; ++d) { const float kvv = bf2f(kr[d]); a0 += q[0][d] * kvv; a1 += q[1][d] * kvv; a2 += q[2][d] * kvv; a3 += q[3][d] * kvv; }
      const int bk = rel_bucket(t - pos);
      s0 = a0 + rel_bias[(g * 4 + 0) * 32 + bk] * LOG2E;
      s1 = a1 + rel_bias[(g * 4 + 1) * 32 + bk] * LOG2E;
      s2 = a2 + rel_bias[(g * 4 + 2) * 32 + bk] * LOG2E;
      s3 = a3 + rel_bias[(g * 4 + 3) * 32 + bk] * LOG2E;
    }
    sc[0][i] = s0; sc[1][i] = s1; sc[2][i] = s2; sc[3][i] = s3;
  }
  __syncthreads();
#pragma unroll
  for (int h = 0; h < 4; ++h) {
    float m = NEGV;
    for (int i = tid; i < nkeys; i += 256) m = fmaxf(m, sc[h][i]);
    m = block_max(m, red);
    float l = 0.f;
    for (int i = tid; i < nkeys; i += 256) { const float sv = sc[h][i]; const float e = (sv > -1e29f) ? exp2f(sv - m) : 0.f; sc[h][i] = e; l += e; }
    l = block_sum(l, red);
    const float inv = 1.f / l;
    for (int i = tid; i < nkeys; i += 256) sc[h][i] *= inv;
  }
  __syncthreads();
  {
    const int d = tid & 127, hp = tid >> 7;
    float o0 = 0.f, o1 = 0.f;
    for (int i = 0; i < nkeys; ++i) {
      const int pos = MODE ? (kstart + i) : (blist[i >> 6] * 64 + (i & 63));
      if (pos <= t) { const float vv = bf2f(Vb[(size_t)pos * HD + d]); o0 += sc[hp * 2][i] * vv; o1 += sc[hp * 2 + 1][i] * vv; }
    }
    const int h0 = g * 4 + hp * 2;
    const size_t i0 = row * 1024 + h0 * HD + d, i1 = row * 1024 + (h0 + 1) * HD + d;
    if (MODE) { OW[i0] = (bf16)f2bf(o0); OW[i1] = (bf16)f2bf(o1); }
    else {
      const float* gr = GATES + row * 24;
      float r0 = gr[h0 * 3 + 0] * bf2f(OC[i0]) + gr[h0 * 3 + 1] * o0; r0 = r0 + gr[h0 * 3 + 2] * bf2f(OW[i0]);
      float r1 = gr[(h0 + 1) * 3 + 0] * bf2f(OC[i1]) + gr[(h0 + 1) * 3 + 1] * o1; r1 = r1 + gr[(h0 + 1) * 3 + 2] * bf2f(OW[i1]);
      AO[row * 2048 + h0 * HD + d] = (bf16)f2bf(r0);
      AO[row * 2048 + (h0 + 1) * HD + d] = (bf16)f2bf(r1);
    }
  }
}

static void launch_mega(const Args& a0, int lo, int hi, int li, int grid, hipStream_t stream) {
    Args a = a0; a.ph_lo = lo; a.ph_hi = hi; a.li = li; a.pad = 0;
    void* params[] = {&a};
    hipError_t e = hipLaunchCooperativeKernel((const void*)mega_fwd, dim3(grid), dim3(NWAVES * 64), params, LDS_BYTES, stream);
    if (e != hipSuccess) fprintf(stderr, "kernel_launch: cooperative launch failed: %s (grid %d)\n", hipGetErrorString(e), grid);
}

extern "C" void kernel_launch(void* const* d_in, const int* in_sizes, int n_in, void* d_out, int out_size, void* d_ws, size_t ws_size, hipStream_t stream) {
    static int grid = 0;
    if (grid == 0) {
        if (n_in != 16 || ws_size < WS_END) { fprintf(stderr, "kernel_launch: unexpected n_in %d or ws_size %zu (< %zu)\n", n_in, ws_size, (size_t)WS_END); grid = -1; return; }
        int dev = 0, cus = 0, per_cu = 0;
        (void)hipGetDevice(&dev); (void)hipDeviceGetAttribute(&cus, hipDeviceAttributeMultiprocessorCount, dev);
        (void)hipFuncSetAttribute((const void*)mega_fwd, hipFuncAttributeMaxDynamicSharedMemorySize, LDS_BYTES);
        (void)hipOccupancyMaxActiveBlocksPerMultiprocessor(&per_cu, (const void*)mega_fwd, NWAVES * 64, LDS_BYTES);
        if (per_cu < 1) { fprintf(stderr, "kernel_launch: occupancy query says %d blocks per CU\n", per_cu); grid = -1; return; }
        grid = cus;
    }
    if (grid < 0) return;
    (void)hipMemsetAsync((char*)d_ws + WS_CTL, 0, CTL_ZERO_BYTES, stream);
    Args a{};
    for (int i = 0; i < 16; ++i) a.in[i] = (const float*)d_in[i];
    a.out = (float*)d_out; a.ws = (unsigned char*)d_ws;
    unsigned char* ws = (unsigned char*)d_ws;
    const float* rel_bias = (const float*)d_in[8];
    launch_mega(a, 0, 4, 0, grid, stream);
    cmp_attn_ref<<<B_ * NKV * T_, 256, 0, stream>>>((const bf16*)(ws + WS_Q), (const bf16*)(ws + WS_KCMP), (const bf16*)(ws + WS_VCMP), rel_bias, (bf16*)(ws + WS_OC),
                                                    (unsigned long long*)(ws + WS_SELM));
    attn_ref<1><<<B_ * NKV * T_, 256, 0, stream>>>((const bf16*)(ws + WS_Q), (const bf16*)(ws + WS_KV), rel_bias, (const unsigned long long*)(ws + WS_SELM),
                                                   (const float*)(ws + WS_GATES), (const bf16*)(ws + WS_OC), (bf16*)(ws + WS_OW), (bf16*)(ws + WS_H));
    attn_ref<0><<<B_ * NKV * T_, 256, 0, stream>>>((const bf16*)(ws + WS_Q), (const bf16*)(ws + WS_KV), rel_bias, (const unsigned long long*)(ws + WS_SELM),
                                                   (const float*)(ws + WS_GATES), (const bf16*)(ws + WS_OC), (bf16*)(ws + WS_OW), (bf16*)(ws + WS_H));
    launch_mega(a, 6, 11, 1, grid, stream);
}
```

```cpp
#include <hip/hip_runtime.h>
#include <cstdio>
#include <cstdint>
namespace pg8 {
#define PG8_LAS __attribute__((address_space(3)))
typedef unsigned short bf16_t;
typedef short bf16x8 __attribute__((ext_vector_type(8)));
typedef float f32x4 __attribute__((ext_vector_type(4)));
typedef unsigned u32x4 __attribute__((ext_vector_type(4)));
constexpr int BM = 256, BK = 64, HALF = 128, HTB = HALF * BK * 2  , STAGE_BYTES = 8 * HTB, NXCD = 8, WGM = 8;

__host__ __device__ __forceinline__ int lds_byte(int r, int c) { const int st = (r >> 4) * 2 + (c >> 5), rr = r & 15, cc = c & 31, ob = rr * 64 + cc * 2; return st * 1024 + (ob ^ (((ob >> 9) & 1) << 5)); }
__host__ __device__ __forceinline__ void stage_rc(int b, int& R, int& C) { const int st = b / 1024, sb = b % 1024, swz = sb ^ (((sb >> 9) & 1) << 5); R = (st >> 1) * 16 + swz / 64; C = (st & 1) * 32 + (swz % 64) / 2; }
__host__ __device__ __forceinline__ int perm32(int rho) { const int n = rho >> 4, i = rho & 15; return 8 * (i >> 2) + 4 * n + (i & 3); }

struct Unit { int pm, pn; };
struct Gemm { const bf16_t* A; const bf16_t* Bt; int M, N, K, lda, ldb; };

struct StaticOrder {
    int nM, nN, nwg, G, c;
    __host__ __device__ void init(int M, int N, int G_, int c_) { nM = M / BM; nN = N / BM; nwg = nM * nN; G = G_; c = c_; }
    __host__ __device__ bool next(int i, Unit& u) const {
        const long L = (long)i * G + c; if (L >= nwg) return false;
        int wgid = (int)L; { const int q = nwg / NXCD, r = nwg % NXCD, xcd = wgid % NXCD, off = wgid / NXCD; wgid = (xcd < r ? xcd * (q + 1) : r * (q + 1) + (xcd - r) * q) + off; }
        const int nig = WGM * nN, gid = wgid / nig, fm = gid * WGM, gsz = (nM - fm) < WGM ? (nM - fm) : WGM;
        u.pm = fm + ((wgid % nig) % gsz); u.pn = (wgid % nig) / gsz; return true;
    }
    __device__ __forceinline__ void a_ready(const Unit&) const {}
    __device__ __forceinline__ void done(const Unit&) const {}
};

__device__ __forceinline__ unsigned cvt_pk_bf16(float lo, float hi) { unsigned r; asm volatile("v_cvt_pk_bf16_f32 %0, %1, %2" : "=v"(r) : "v"(lo), "v"(hi)); return r; }
typedef float f32x2 __attribute__((ext_vector_type(2)));
struct EpiF32 {
    static constexpr bool PERM = false, AFTER_DRAIN = false;
    float* C; int ldc;
    __device__ __forceinline__ void operator()(const f32x4 (&acc)[2][2][4][2], const Unit& u, int wr, int wc, int fr, int fq) const {
        const int row0 = u.pm * BM + wr * 64 + fr, col0 = u.pn * BM + wc * 32 + 4 * fq;
#pragma unroll
        for (int ai = 0; ai < 2; ++ai)
#pragma unroll
            for (int m = 0; m < 4; ++m) { float* rowp = C + (size_t)(row0 + ai * HALF + m * 16) * ldc + col0;
#pragma unroll
                for (int bj = 0; bj < 2; ++bj)
#pragma unroll
                    for (int n = 0; n < 2; ++n) *(f32x4*)(rowp + bj * HALF + n * 16) = acc[ai][bj][m][n]; }
    }
};
struct EpiRelu2Bf16 {
    static constexpr bool PERM = true, AFTER_DRAIN = false;
    bf16_t* O; int ldc;
    __device__ __forceinline__ void operator()(const f32x4 (&acc)[2][2][4][2], const Unit& u, int wr, int wc, int fr, int fq) const {
        const int row0 = u.pm * BM + wr * 64 + fr, col0 = u.pn * BM + wc * 32 + 8 * fq;
#pragma unroll
        for (int ai = 0; ai < 2; ++ai)
#pragma unroll
            for (int m = 0; m < 4; ++m) { bf16_t* rowp = O + (size_t)(row0 + ai * HALF + m * 16) * ldc + col0;
#pragma unroll
                for (int bj = 0; bj < 2; ++bj) { f32x4 v0 = acc[ai][bj][m][0], v1 = acc[ai][bj][m][1];
#pragma unroll
                    for (int e = 0; e < 4; ++e) { v0[e] = v0[e] > 0.f ? v0[e] : 0.f; v1[e] = v1[e] > 0.f ? v1[e] : 0.f; }
                    v0 = v0 * v0; v1 = v1 * v1;
                    u32x4 w; w.x = cvt_pk_bf16(v0[0], v0[1]); w.y = cvt_pk_bf16(v0[2], v0[3]); w.z = cvt_pk_bf16(v1[0], v1[1]); w.w = cvt_pk_bf16(v1[2], v1[3]);
                    *(u32x4*)(rowp + bj * HALF) = w; } }
    }
};
struct EpiInProj {
    static constexpr bool PERM = true, AFTER_DRAIN = false;
    bf16_t* Q; bf16_t* KV; bf16_t* C3; float* gates; float qscale;
    __device__ __forceinline__ void operator()(const f32x4 (&acc)[2][2][4][2], const Unit& u, int wr, int wc, int fr, int fq) const {
        const int pn = u.pn;
        const int row0 = u.pm * BM + wr * 64 + fr, cc0 = wc * 32 + 8 * fq;
#pragma unroll
        for (int ai = 0; ai < 2; ++ai)
#pragma unroll
            for (int m = 0; m < 4; ++m) { const int r = row0 + ai * HALF + m * 16;
#pragma unroll
                for (int bj = 0; bj < 2; ++bj) { f32x4 v0 = acc[ai][bj][m][0], v1 = acc[ai][bj][m][1];
                    const int cc = cc0 + bj * HALF;
                    if (pn == 22) {
                        if (bj == 0 && cc < 24) {
#pragma unroll
                            for (int e = 0; e < 4; ++e) { gates[(size_t)r * 24 + cc + e] = 1.f / (1.f + __expf(-v0[e])); gates[(size_t)r * 24 + cc + 4 + e] = 1.f / (1.f + __expf(-v1[e])); }
                        }
                    } else {
                        bf16_t* dst;
                        if (pn < 4) { v0 = v0 * qscale; v1 = v1 * qscale; dst = Q + (size_t)r * 1024 + pn * 256 + cc; }
                        else if (pn < 10) { const int b = r >> 12, t = r & 4095; dst = KV + (size_t)(pn - 4) * (4 * 4096 * 128) + ((size_t)((b * 2 + bj) * 4096 + t)) * 128 + cc0; }
                        else { const int idx = (pn - 10) >> 2; dst = C3 + (size_t)idx * (8192 * 1024) + (size_t)r * 1024 + ((pn - 10) & 3) * 256 + cc; }
                        u32x4 w; w.x = cvt_pk_bf16(v0[0], v0[1]); w.y = cvt_pk_bf16(v0[2], v0[3]); w.z = cvt_pk_bf16(v1[0], v1[1]); w.w = cvt_pk_bf16(v1[2], v1[3]);
                        *(u32x4*)dst = w;
                    } } }
    }
};
struct OneUnit {
    bool has; Unit u;
    __device__ __forceinline__ bool next(int i, Unit& o) const { if (i == 0 && has) { o = u; return true; } return false; }
    __device__ __forceinline__ void a_ready(const Unit&) const {}
    __device__ __forceinline__ void done(const Unit&) const {}
};

template <class Epi, class Sched, bool ALIGN_EPI = false, bool SP2 = false>
__device__ __forceinline__ void gemm_phase(PG8_LAS unsigned char* lds, const Gemm g, const Sched& S, const Epi& E) {
    const int tid = threadIdx.x, wid = __builtin_amdgcn_readfirstlane(tid >> 6), lane = tid & 63, wr = wid >> 2, wc = wid & 3, fr = lane & 15, fq = lane >> 4;
    const int K = g.K, nt = K / BK;
    unsigned voffA[2], voffB[2];
#pragma unroll
    for (int i = 0; i < 2; ++i) { int R, C; stage_rc(tid * 16 + i * 8192, R, C); const int Rb = Epi::PERM ? ((R & ~31) + perm32(R & 31)) : R;
        voffA[i] = (unsigned)(R * g.lda + C) * 2u; voffB[i] = (unsigned)(Rb * g.ldb + C) * 2u; }
    const size_t kstep = (size_t)(BK * 2);
    const size_t hstepA = (size_t)HALF * g.lda * 2, hstepB = (size_t)HALF * g.ldb * 2;
    const size_t tstepA = 2 * hstepA, tstepB = 2 * hstepB;
    const unsigned ldsw = (unsigned)wid * 1024u;
    const int aoff = lds_byte(wr * 64 + fr, fq * 8), boff = lds_byte(wc * 32 + fr, fq * 8);
#define PG8_SA(b, h) (((b) * 2 + (h)) * HTB)
#define PG8_SB(b, h) ((4 + (b) * 2 + (h)) * HTB)
#define PG8_STAGE(bufoff, gbase, voff) do { _Pragma("unroll") for (int _i = 0; _i < 2; ++_i) \
        __builtin_amdgcn_global_load_lds((const unsigned*)((const char*)(gbase) + (voff)[_i]), (PG8_LAS unsigned*)(lds + (bufoff) + ldsw + _i * 8192), 16, 0, 0); } while (0)
#define PG8_LDA(dst, b, h) do { _Pragma("unroll") for (int m = 0; m < 4; ++m) _Pragma("unroll") for (int k = 0; k < 2; ++k) dst[m][k] = *(const PG8_LAS bf16x8*)(lds + PG8_SA(b, h) + aoff + m * 2048 + k * 1024); } while (0)
#define PG8_LDB(dst, b, h) do { _Pragma("unroll") for (int n = 0; n < 2; ++n) _Pragma("unroll") for (int k = 0; k < 2; ++k) dst[n][k] = *(const PG8_LAS bf16x8*)(lds + PG8_SB(b, h) + boff + n * 2048 + k * 1024); } while (0)
#define PG8_MMA(ai, bj, At, Bt) do { __builtin_amdgcn_s_setprio(1); _Pragma("unroll") for (int m = 0; m < 4; ++m) _Pragma("unroll") for (int n = 0; n < 2; ++n) _Pragma("unroll") for (int k = 0; k < 2; ++k) \
        acc[ai][bj][m][n] = __builtin_amdgcn_mfma_f32_16x16x32_bf16(Bt[n][k], At[m][k], acc[ai][bj][m][n], 0, 0, 0); __builtin_amdgcn_s_setprio(0); } while (0)
#define PG8_WAIT_V(n) asm volatile("s_waitcnt vmcnt(" #n ")" ::: "memory")
#define PG8_WAIT_L(n) asm volatile("s_waitcnt lgkmcnt(" #n ")" ::: "memory")
#define PG8_BAR __builtin_amdgcn_s_barrier()
#define PG8_SCHED __builtin_amdgcn_sched_barrier(0)
    Unit cur, nxt; int ui = 0;
    if (!S.next(0, cur)) return;
    f32x4 acc[2][2][4][2];
#pragma unroll
    for (int a = 0; a < 2; ++a)
#pragma unroll
        for (int b = 0; b < 2; ++b)
#pragma unroll
            for (int m = 0; m < 4; ++m)
#pragma unroll
                for (int n = 0; n < 2; ++n) acc[a][b][m][n] = (f32x4){0.f, 0.f, 0.f, 0.f};
    bf16x8 At[4][2], B0[2][2], B1[2][2];
    const char* cA = (const char*)g.A + (size_t)cur.pm * tstepA; const char* cB = (const char*)g.Bt + (size_t)cur.pn * tstepB;
    S.a_ready(cur);
    if constexpr (SP2) {
        PG8_STAGE(PG8_SB(0, 0), cB, voffB); PG8_STAGE(PG8_SB(0, 1), cB + hstepB, voffB); PG8_STAGE(PG8_SA(0, 0), cA, voffA); PG8_STAGE(PG8_SA(0, 1), cA + hstepA, voffA);
        if (wr == 1) PG8_BAR;
        PG8_WAIT_V(2); PG8_BAR;
        PG8_STAGE(PG8_SB(1, 0), cB + kstep, voffB); PG8_STAGE(PG8_SA(1, 0), cA + kstep, voffA); PG8_STAGE(PG8_SB(1, 1), cB + hstepB + kstep, voffB);
        PG8_WAIT_V(6); PG8_BAR;
    } else {
        PG8_STAGE(PG8_SB(0, 0), cB, voffB); PG8_STAGE(PG8_SA(0, 0), cA, voffA); PG8_STAGE(PG8_SB(0, 1), cB + hstepB, voffB); PG8_STAGE(PG8_SA(0, 1), cA + hstepA, voffA);
        if (wr == 1) PG8_BAR;
        PG8_WAIT_V(4); PG8_BAR;
        PG8_STAGE(PG8_SB(1, 0), cB + kstep, voffB); PG8_STAGE(PG8_SA(1, 0), cA + kstep, voffA); PG8_STAGE(PG8_SB(1, 1), cB + hstepB + kstep, voffB);
        PG8_WAIT_V(6); PG8_BAR;
    }
    for (;;) {
        const bool has_next = S.next(ui + 1, nxt);
        const char* nA = has_next ? (const char*)g.A + (size_t)nxt.pm * tstepA : cA; const char* nB = has_next ? (const char*)g.Bt + (size_t)nxt.pn * tstepB : cB;
        for (int t = 0; t < nt; t += 2) {
            const bool last = (t == nt - 2);
            const char* a1 = cA + (size_t)(t + 1) * kstep;
            const char* a2 = last ? nA : cA + (size_t)(t + 2) * kstep; const char* b2 = last ? nB : cB + (size_t)(t + 2) * kstep;
            const char* a3 = a2 + kstep; const char* b3 = b2 + kstep;
            if (last && has_next) S.a_ready(nxt);
            if constexpr (SP2) {
            PG8_LDB(B0, 0, 0); PG8_LDB(B1, 0, 1); PG8_SCHED; PG8_LDA(At, 0, 0); PG8_STAGE(PG8_SA(1, 1), a1 + hstepA, voffA);
            PG8_WAIT_V(8); PG8_WAIT_L(0); PG8_BAR; PG8_MMA(0, 0, At, B0); PG8_MMA(0, 1, At, B1); PG8_BAR; PG8_SCHED;
            PG8_LDA(At, 0, 1); PG8_STAGE(PG8_SB(0, 0), b2, voffB); PG8_STAGE(PG8_SB(0, 1), b2 + hstepB, voffB); PG8_STAGE(PG8_SA(0, 0), a2, voffA);
            PG8_WAIT_V(8); PG8_WAIT_L(0); PG8_BAR; PG8_MMA(1, 0, At, B0); PG8_MMA(1, 1, At, B1); PG8_BAR; PG8_SCHED;
            PG8_LDB(B0, 1, 0); PG8_LDB(B1, 1, 1); PG8_SCHED; PG8_LDA(At, 1, 0); PG8_STAGE(PG8_SA(0, 1), a2 + hstepA, voffA);
            PG8_WAIT_V(8); PG8_WAIT_L(0); PG8_BAR; PG8_MMA(0, 0, At, B0); PG8_MMA(0, 1, At, B1); PG8_BAR; PG8_SCHED;
            PG8_LDA(At, 1, 1); PG8_STAGE(PG8_SB(1, 0), b3, voffB); PG8_STAGE(PG8_SB(1, 1), b3 + hstepB, voffB); PG8_STAGE(PG8_SA(1, 0), a3, voffA);
            PG8_WAIT_V(8); PG8_WAIT_L(0); PG8_BAR; PG8_MMA(1, 0, At, B0); PG8_MMA(1, 1, At, B1); PG8_BAR; PG8_SCHED;
            } else {
            PG8_LDB(B0, 0, 0); PG8_SCHED; PG8_LDA(At, 0, 0); PG8_STAGE(PG8_SA(1, 1), a1 + hstepA, voffA);
            PG8_WAIT_L(8); PG8_BAR; PG8_WAIT_L(0); PG8_MMA(0, 0, At, B0); PG8_BAR; PG8_SCHED;
            PG8_LDB(B1, 0, 1); PG8_STAGE(PG8_SB(0, 0), b2, voffB);
            PG8_BAR; PG8_WAIT_L(0); PG8_MMA(0, 1, At, B1); PG8_BAR;
            PG8_LDA(At, 0, 1); PG8_STAGE(PG8_SA(0, 0), a2, voffA);
            PG8_BAR; PG8_WAIT_L(0); PG8_MMA(1, 0, At, B0); PG8_BAR; PG8_SCHED;
            PG8_STAGE(PG8_SB(0, 1), b2 + hstepB, voffB);
            PG8_WAIT_V(6); PG8_BAR; PG8_MMA(1, 1, At, B1); PG8_BAR;
            PG8_LDB(B0, 1, 0); PG8_SCHED; PG8_LDA(At, 1, 0); PG8_STAGE(PG8_SA(0, 1), a2 + hstepA, voffA);
            PG8_WAIT_L(8); PG8_BAR; PG8_WAIT_L(0); PG8_MMA(0, 0, At, B0); PG8_BAR; PG8_SCHED;
            PG8_LDB(B1, 1, 1); PG8_STAGE(PG8_SB(1, 0), b3, voffB);
            PG8_BAR; PG8_WAIT_L(0); PG8_MMA(0, 1, At, B1); PG8_BAR;
            PG8_LDA(At, 1, 1); PG8_STAGE(PG8_SA(1, 0), a3, voffA);
            PG8_BAR; PG8_WAIT_L(0); PG8_MMA(1, 0, At, B0); PG8_BAR; PG8_SCHED;
            PG8_STAGE(PG8_SB(1, 1), b3 + hstepB, voffB);
            PG8_WAIT_V(6); PG8_BAR; PG8_MMA(1, 1, At, B1); PG8_BAR;
            }
        }
        if constexpr (ALIGN_EPI) { if (wr == 0) PG8_BAR; }
        if constexpr (!Epi::AFTER_DRAIN) { E(acc, cur, wr, wc, fr, fq); S.done(cur); }
        if (!has_next) break;
#pragma unroll
        for (int a = 0; a < 2; ++a)
#pragma unroll
            for (int b = 0; b < 2; ++b)
#pragma unroll
                for (int m = 0; m < 4; ++m)
#pragma unroll
                    for (int n = 0; n < 2; ++n) acc[a][b][m][n] = (f32x4){0.f, 0.f, 0.f, 0.f};
        cur = nxt; cA = nA; cB = nB; ++ui;
        if constexpr (ALIGN_EPI) { if (wr == 1) PG8_BAR; }
    }
    PG8_WAIT_V(0);
    if constexpr (!ALIGN_EPI) { if (wr == 0) PG8_BAR; }
    PG8_BAR;
    if constexpr (Epi::AFTER_DRAIN) { E.fused(acc, cur, wr, wc, fr, fq, lds, wid, lane); S.done(cur); }
#undef PG8_SA
#undef PG8_SB
#undef PG8_STAGE
#undef PG8_LDA
#undef PG8_LDB
#undef PG8_MMA
#undef PG8_WAIT_V
#undef PG8_WAIT_L
#undef PG8_BAR
#undef PG8_SCHED
}
}
#define GAS __attribute__((address_space(1)))
#define LAS __attribute__((address_space(3)))
typedef unsigned short bf16;
typedef unsigned v4u __attribute__((ext_vector_type(4)));
typedef float f32x4 __attribute__((ext_vector_type(4)));
typedef short bf16x8 __attribute__((ext_vector_type(8)));
typedef GAS unsigned gu32;
typedef GAS unsigned long long gu64;
#define RLX_AGENT __ATOMIC_RELAXED, __HIP_MEMORY_SCOPE_AGENT
#define LDS_WAIT() asm volatile("s_waitcnt lgkmcnt(0)" ::: "memory")
#define VM_WAIT() asm volatile("s_waitcnt vmcnt(0)" ::: "memory")
__device__ __forceinline__ unsigned long long rt() { return __builtin_amdgcn_s_memrealtime(); }
__device__ __forceinline__ unsigned f2bf(float f) { unsigned u = __builtin_bit_cast(unsigned, f); return (u + 0x7fffu + ((u >> 16) & 1u)) >> 16; }
__device__ __forceinline__ unsigned pk2(float lo, float hi) { return f2bf(lo) | (f2bf(hi) << 16); }

#define XB_TMO      128
#define XB_XCNT(j)  (256  + 64 * (j))
#define XB_XSUB(j)  (1280 + 64 * (j))
#define XB_XGEN(j)  (2304 + 64 * (j))
#define XB_TOP      3328
#define XB_TOPGEN   3392
#define XCD_BAR_WORDS 3456
#define XB_SPIN_CAP (1u << 18)

__device__ __forceinline__ unsigned xb_ld(unsigned* p)              { return __hip_atomic_load(p, __ATOMIC_RELAXED, __HIP_MEMORY_SCOPE_AGENT); }
__device__ __forceinline__ unsigned xb_add(unsigned* p, unsigned v) { return __hip_atomic_fetch_add(p, v, __ATOMIC_RELAXED, __HIP_MEMORY_SCOPE_AGENT); }
__device__ __forceinline__ unsigned xb_xcc_id() { return (unsigned)__builtin_amdgcn_s_getreg((3 << 11) | 20) & 0xFu; }
#define XB_SPIN(cond, bar) do { unsigned _sp = 0; while (cond) { __builtin_amdgcn_s_sleep(1); \
    if ((++_sp & 255u) == 0u) { if (xb_ld(&(bar)[XB_TMO])) break; if (_sp > XB_SPIN_CAP) { atomicAdd(&(bar)[XB_TMO], 1u); break; } } } } while (0)

struct XcdBarrier {
    unsigned* bar; unsigned x;
    volatile LAS unsigned* st;
};

__device__ __forceinline__ XcdBarrier xcd_barrier_post(unsigned* bar, volatile LAS unsigned* st) {
    XcdBarrier b; b.bar = bar; b.x = xb_xcc_id(); b.st = st;
    if (threadIdx.x == 0) (void)xb_add(&bar[XB_XCNT(b.x)], 1u);
    return b;
}
__device__ __forceinline__ void xcd_barrier_complete(unsigned* bar, unsigned x, unsigned& nloc, unsigned& nx) {
    const unsigned G = gridDim.x * gridDim.y * gridDim.z;
    unsigned sum, cnt, mine, sp = 0u;
    for (;;) {
        sum = 0u; cnt = 0u; mine = 0u;
#pragma unroll
        for (unsigned j = 0; j < 16; ++j) { const unsigned c = xb_ld(&bar[XB_XCNT(j)]); sum += c; cnt += (c > 0u) ? 1u : 0u; mine = (j == x) ? c : mine; }
        if (sum == G) break;
        __builtin_amdgcn_s_sleep(1);
        if ((++sp & 255u) == 0u) { if (xb_ld(&bar[XB_TMO])) break; if (sp > XB_SPIN_CAP) { atomicAdd(&bar[XB_TMO], 1u); break; } }
    }
    nloc = mine > 0u ? mine : 1u; nx = cnt > 0u ? cnt : 1u;
}

__device__ __forceinline__ void xcd_barrier(const XcdBarrier& b) {
    asm volatile("s_waitcnt vmcnt(0)" ::: "memory");
    __syncthreads();
    if (threadIdx.x == 0) {
        unsigned* bar = b.bar;
        __builtin_amdgcn_s_waitcnt(0);
        unsigned nloc = b.st[0], nx = b.st[1];
        if (nloc == 0u) { xcd_barrier_complete(bar, b.x, nloc, nx); b.st[0] = nloc; b.st[1] = nx; }
        const unsigned old = xb_add(&bar[XB_XSUB(b.x)], 1u);
        const unsigned gen = old / nloc;
        if (old + 1u == (gen + 1u) * nloc) {
            __builtin_amdgcn_fence(__ATOMIC_RELEASE, "agent");
            asm volatile("s_waitcnt vmcnt(0)" ::: "memory");
            const unsigned og = xb_add(&bar[XB_TOP], 1u);
            const unsigned tg = og / nx;
            if (og + 1u == (tg + 1u) * nx) xb_add(&bar[XB_TOPGEN], 1u);
            else XB_SPIN(xb_ld(&bar[XB_TOPGEN]) == tg, bar);
            __builtin_amdgcn_fence(__ATOMIC_ACQUIRE, "agent");
            xb_add(&bar[XB_XGEN(b.x)], 1u);
            asm volatile("s_waitcnt vmcnt(0)" ::: "memory");
        } else {
            XB_SPIN(xb_ld(&bar[XB_XGEN(b.x)]) == gen, bar);
            __builtin_amdgcn_fence(__ATOMIC_ACQUIRE, "agent");
            asm volatile("s_waitcnt vmcnt(0)" ::: "memory");
        }
    }
    __syncthreads();
}
constexpr int NWAVES = 8;
constexpr int B_ = 2, T_ = 4096, D_ = 2048, M_ = B_ * T_;
constexpr int NKV = 2, HD = 128, NCMP = 255, NSEL = 64, TOPK = 16, WIN = 512;
constexpr int DFF = 8192, INW = 5656, NQT = 5888;
constexpr float EPS = 1e-6f, NEGV = -1e30f, FORCEV = 1e9f;
constexpr float LOG2E = 1.4426950408889634f;
constexpr float QSCALE = 0.08838834764831845f * 1.4426950408889634f;

constexpr size_t MiB = 1u << 20;
constexpr size_t WS_CTL = 0, CTL_ZERO_BYTES = 131072;
constexpr size_t WS_PEB = 1 * MiB;
constexpr size_t WS_SELM = 1 * MiB + 128 * 1024;
constexpr size_t WS_KCMP = 1 * MiB + 256 * 1024;
constexpr size_t WS_VCMP = 1 * MiB + 512 * 1024;
constexpr size_t WS_GATES = 2 * MiB;
constexpr size_t WS_WDN = 4 * MiB, WS_WUP = 36 * MiB;
constexpr size_t WS_H = 68 * MiB;
constexpr size_t WS_F = 36 * MiB;
constexpr size_t WS_U = 100 * MiB;
constexpr size_t WS_WIN = 100 * MiB;
constexpr size_t WS_SLAB = 100 * MiB;
constexpr size_t WS_WO = 124 * MiB;
constexpr size_t WS_W1 = 132 * MiB;
constexpr size_t WS_Q = 136 * MiB;
constexpr size_t WS_KV = 152 * MiB;
constexpr size_t WS_C3 = 176 * MiB;
constexpr size_t WS_OC = 228 * MiB, WS_OW = 244 * MiB;
constexpr size_t WS_END = 260 * MiB;
constexpr size_t KVSZ = (size_t)4 * 4096 * 128;

constexpr int RING_BYTES = 135168;
constexpr int LDSCTL_OFF = RING_BYTES, MISC_OFF = LDSCTL_OFF + 320;
constexpr int LDS_BYTES = RING_BYTES + 1024;

__device__ __constant__ unsigned char BUCKET_TAB[128] = {
  0, 1, 2, 3, 4, 5, 6, 7, 8, 9, 10, 11, 12, 13, 14, 15, 16, 16, 16, 17, 17, 18, 18, 18, 19, 19, 19, 20, 20, 20, 20, 21, 21, 21, 21, 22, 22, 22, 22, 22,
  23, 23, 23, 23, 23, 23, 24, 24, 24, 24, 24, 24, 25, 25, 25, 25, 25, 25, 25, 26, 26, 26, 26, 26, 26, 26, 26, 27, 27, 27, 27, 27, 27, 27, 27, 27, 27,
  28, 28, 28, 28, 28, 28, 28, 28, 28, 28, 29, 29, 29, 29, 29, 29, 29, 29, 29, 29, 29, 29, 30, 30, 30, 30, 30, 30, 30, 30, 30, 30, 30, 30, 30, 30,
  31, 31, 31, 31, 31, 31, 31, 31, 31, 31, 31, 31, 31, 31, 31};
__device__ __forceinline__ int rel_bucket(int dist) { int n = dist < 0 ? 0 : dist; return n >= 113 ? 31 : (int)BUCKET_TAB[n]; }
__device__ __forceinline__ int rel_bucket_arith(int n) {
    int r = 16 + (n >= 19) + (n >= 21) + (n >= 24) + (n >= 27) + (n >= 31) + (n >= 35) + (n >= 40) + (n >= 46) + (n >= 52) + (n >= 59) + (n >= 67) + (n >= 77) + (n >= 87) + (n >= 99) + (n >= 113);
    return n < 16 ? n : r;
}
__device__ __forceinline__ float bf2f(unsigned short v) { return __builtin_bit_cast(float, (unsigned)v << 16); }

__device__ __forceinline__ float wave_sum(float v) {
#pragma unroll
    for (int o = 1; o < 64; o <<= 1) v += __shfl_xor(v, o);
    return v;
}

__device__ __forceinline__ int win_src_col(int n) { return n < 2560 ? n : (n < 5632 ? n + 24 : (n < 5656 ? n - 5632 + 2560 : -1)); }
__device__ __forceinline__ void p0_transpose_item(const float* W, int ldw, int K, int nblk, bf16* WT, LAS float* scr, int item, int lane, bool remap) {
    const int kb = item / nblk, nb = item % nblk, k0 = 64 * kb, n0 = 32 * nb;
    const int nn = n0 + (lane & 31); const int sc = remap ? win_src_col(nn) : nn;
#pragma unroll 8
    for (int i = 0; i < 32; ++i) { const int kk = 2 * i + (lane >> 5); scr[kk * 33 + (lane & 31)] = sc >= 0 ? W[(size_t)(k0 + kk) * ldw + sc] : 0.f; }
    LDS_WAIT(); asm volatile("" ::: "memory");
    const int c = lane & 7;
#pragma unroll
    for (int j = 0; j < 4; ++j) { const int n = (lane >> 3) + 8 * j; const LAS float* s = scr + (8 * c) * 33 + n;
        v4u o; o.x = pk2(s[0 * 33], s[1 * 33]); o.y = pk2(s[2 * 33], s[3 * 33]); o.z = pk2(s[4 * 33], s[5 * 33]); o.w = pk2(s[6 * 33], s[7 * 33]);
        *(GAS v4u*)(WT + (size_t)(n0 + n) * K + k0 + 8 * c) = o; }
    LDS_WAIT(); asm volatile("" ::: "memory");
}
__device__ __forceinline__ void rms_row_to_bf16(const float* xrow, const float* gain, bf16* orow, int lane) {
    const GAS f32x4* xr = (const GAS f32x4*)xrow + lane; const GAS f32x4* gr = (const GAS f32x4*)gain + lane;
    f32x4 v[8]; float s = 0.f;
#pragma unroll
    for (int j = 0; j < 8; ++j) { v[j] = xr[64 * j]; s += (v[j].x * v[j].x + v[j].y * v[j].y) + (v[j].z * v[j].z + v[j].w * v[j].w); }
    const float r = rsqrtf(wave_sum(s) * (1.f / D_) + EPS);
    GAS unsigned long long* o8 = (GAS unsigned long long*)orow + lane;
#pragma unroll
    for (int j = 0; j < 8; ++j) { const f32x4 g = gr[64 * j];
        o8[64 * j] = (unsigned long long)pk2((v[j].x * r) * g.x, (v[j].y * r) * g.y) | ((unsigned long long)pk2((v[j].z * r) * g.z, (v[j].w * r) * g.w) << 32); }
}

namespace att {
typedef short bf16x8 __attribute__((ext_vector_type(8)));
typedef short s16x4 __attribute__((ext_vector_type(4)));
typedef float f32x16 __attribute__((ext_vector_type(16)));
typedef float f32x2_t __attribute__((ext_vector_type(2)));
typedef __bf16 bf16x2_t __attribute__((ext_vector_type(2)));
typedef short v4i16_t __attribute__((ext_vector_type(4)));
typedef LAS const char* lcp;
__device__ __forceinline__ unsigned cvtpk(float lo, float hi) { f32x2_t v = {lo, hi}; bf16x2_t b = __builtin_convertvector(v, bf16x2_t); return __builtin_bit_cast(unsigned, b); }
__device__ __forceinline__ s16x4 vtr(lcp p) { return __builtin_bit_cast(s16x4, __builtin_amdgcn_ds_read_tr16_b64_v4i16((LAS v4i16_t*)p)); }

constexpr int KB0 = 0, VB0 = 32768, BIAS_OFF = 65536, IMP_OFF = 65536 + 2048, IMP_FLOATS = 2 * 4 * 64 * 33;
constexpr float MINIT = -1e29f, MASKED = -1e30f;

struct TileRegs { v4u k[2], v[2]; };
__device__ __forceinline__ void tile_load(TileRegs& R, const bf16* Kg, const bf16* Vg, int tid) {
#pragma unroll
    for (int i = 0; i < 2; ++i) { const int ci = tid + 512 * i;
        R.k[i] = *(const GAS v4u*)((const char*)Kg + ci * 16); R.v[i] = *(const GAS v4u*)((const char*)Vg + ci * 16); }
}
__device__ __forceinline__ void tile_store(LAS unsigned char* lds, int buf, const TileRegs& R, int tid) {
#pragma unroll
    for (int i = 0; i < 2; ++i) { const int ci = tid + 512 * i, row = ci >> 4, ch = ci & 15;
        *(LAS v4u*)(lds + KB0 + buf * 16384 + row * 256 + ((ch ^ (row & 15)) << 4)) = R.k[i];
        *(LAS v4u*)(lds + VB0 + buf * 16384 + row * 256 + ((ch ^ (((row & 3) << 2) | ((row >> 2) & 3))) << 4)) = R.v[i]; }
}
__device__ __forceinline__ void qk_tile(f32x16& p0, f32x16& p1, lcp kb, const bf16x8 (&qf)[8], int lane) {
    const int r = lane & 31, h2 = lane >> 5;
#pragma unroll
    for (int e = 0; e < 16; ++e) { p0[e] = 0.f; p1[e] = 0.f; }
    lcp k0 = kb + r * 256, k1 = kb + (r + 32) * 256;
#pragma unroll
    for (int s = 0; s < 8; ++s) { const int off = ((2 * s + h2) ^ (r & 15)) << 4;
        const bf16x8 a0 = *(const LAS bf16x8*)(k0 + off), a1 = *(const LAS bf16x8*)(k1 + off);
        p0 = __builtin_amdgcn_mfma_f32_32x32x16_bf16(a0, qf[s], p0, 0, 0, 0);
        p1 = __builtin_amdgcn_mfma_f32_32x32x16_bf16(a1, qf[s], p1, 0, 0, 0); }
}
__device__ __forceinline__ void pv_tile(f32x16 (&o)[4], lcp vb, const bf16x8 (&pf)[4], int lane) {
    const int i16 = lane & 15, q4 = i16 >> 2, p4 = i16 & 3, gl = (lane >> 4) & 1, h2 = lane >> 5;
#pragma unroll
    for (int s = 0; s < 4; ++s) { const int base = 32 * (s >> 1) + 16 * (s & 1);
        const int key1 = base + 4 * h2 + q4, key2 = key1 + 8;
        const int sw1 = ((key1 & 3) << 2) | ((key1 >> 2) & 3), sw2 = ((key2 & 3) << 2) | ((key2 >> 2) & 3);
        lcp r1 = vb + key1 * 256 + 8 * (p4 & 1), r2 = vb + key2 * 256 + 8 * (p4 & 1);
#pragma unroll
        for (int db = 0; db < 4; ++db) { const int ch = 4 * db + 2 * gl + (p4 >> 1);
            const s16x4 lo = vtr(r1 + ((ch ^ sw1) << 4)), hi = vtr(r2 + ((ch ^ sw2) << 4));
            bf16x8 a; a[0] = lo[0]; a[1] = lo[1]; a[2] = lo[2]; a[3] = lo[3]; a[4] = hi[0]; a[5] = hi[1]; a[6] = hi[2]; a[7] = hi[3];
            o[db] = __builtin_amdgcn_mfma_f32_32x32x16_bf16(a, pf[s], o[db], 0, 0, 0); } }
}
#define ATT_OFF(r) (((r) & 3) + 8 * ((r) >> 2))
#define LADD(p, v) (void)__hip_atomic_fetch_add((p), (v), __ATOMIC_RELAXED, __HIP_MEMORY_SCOPE_WORKGROUP)

struct AttnBufs { const bf16* Q; const bf16* K; const bf16* V; int kvrows;
                  const float* rel_bias; const unsigned long long* selm_in; unsigned long long* selm_out; const float* gates;
                  bf16* OC; bf16* OW; bf16* AO; };

template <int MODE>
__device__ __forceinline__ void attn_item(LAS unsigned char* lds, const AttnBufs& P, int b, int g, int qA0, int qB0, int tid, int lane, int wave) {
    const int half = wave >> 2, hh = wave & 3, head = g * 4 + hh, bg = b * NKV + g;
    const int q0 = half ? qB0 : qA0, ql = lane & 31, hi = lane >> 5, t = q0 + ql;
    const size_t row = (size_t)b * T_ + t;
    int jlo_w, jhi_w, jlo_g, jhi_g;
    if (MODE == 0) { jlo_w = 0; jhi_w = (q0 + 31) >> 6; jlo_g = 0; const int qm = qA0 > qB0 ? qA0 : qB0; jhi_g = (qm + 31) >> 6; }
    else if (MODE == 1) { const int lo_ = q0 - (WIN - 1); jlo_w = lo_ < 0 ? 0 : (lo_ >> 6); jhi_w = (q0 + 31) >> 6;
                          const int qn = qA0 < qB0 ? qA0 : qB0, qm = qA0 > qB0 ? qA0 : qB0; const int lg = qn - (WIN - 1); jlo_g = lg < 0 ? 0 : (lg >> 6); jhi_g = (qm + 31) >> 6; }
    else { jlo_w = 0; jhi_w = q0 >> 10; jlo_g = 0; const int qm = qA0 > qB0 ? qA0 : qB0; jhi_g = qm >> 10; }
    const bf16* Kg = P.K + (size_t)bg * P.kvrows * HD; const bf16* Vg = P.V + (size_t)bg * P.kvrows * HD;
    { const int h_ = tid >> 7, idx = tid & 127; ((LAS float*)(lds + BIAS_OFF))[tid] = idx <= 113 ? P.rel_bias[(g * 4 + h_) * 32 + rel_bucket_arith(idx)] * LOG2E : 0.f; }
    if (MODE == 2) { for (int i = tid; i < IMP_FLOATS; i += 512) ((LAS float*)(lds + IMP_OFF))[i] = 0.f; }
    bf16x8 qf[8];
    { const bf16* qp = P.Q + row * 1024 + head * HD + 8 * hi;
#pragma unroll
      for (int s = 0; s < 8; ++s) qf[s] = *(const GAS bf16x8*)(qp + 16 * s); }
    unsigned long long selm = 0ull;
    if (MODE == 0) selm = P.selm_in[(size_t)bg * T_ + t];
    const LAS float* bt = (const LAS float*)(lds + BIAS_OFF) + hh * 128;
    f32x16 o[4];
#pragma unroll
    for (int d = 0; d < 4; ++d)
#pragma unroll
        for (int e = 0; e < 16; ++e) o[d][e] = 0.f;
    float m = MINIT, l = 0.f, invl = 0.f;
    const int cmax = (MODE == 2) ? (((t - 31) >> 4) < 254 ? ((t - 31) >> 4) : 254) : 0;

    constexpr int NPASS = (MODE == 2) ? 2 : 1;
#pragma unroll 1
    for (int pass = 0; pass < NPASS; ++pass) {
        TileRegs R;
        tile_load(R, Kg + (size_t)jlo_g * 64 * HD, Vg + (size_t)jlo_g * 64 * HD, tid);
        tile_store(lds, 0, R, tid);
        __syncthreads();
#pragma unroll 1
        for (int j = jlo_g; j <= jhi_g; ++j) {
            const int cur = (j - jlo_g) & 1;
            const bool more = j < jhi_g;
            if (more) tile_load(R, Kg + (size_t)(j + 1) * 64 * HD, Vg + (size_t)(j + 1) * 64 * HD, tid);
            if (j >= jlo_w && j <= jhi_w) {
                f32x16 p0, p1;
                qk_tile(p0, p1, (lcp)(lds + KB0 + cur * 16384), qf, lane);
                float mx = MASKED;
                if (MODE == 2) {
                    const int c0 = 64 * j + 4 * hi, dd0 = t - 31 - 16 * c0;
#pragma unroll
                    for (int r = 0; r < 16; ++r) {
                        { const int c = c0 + ATT_OFF(r), dist = dd0 - 16 * ATT_OFF(r); const int idx = dist < 0 ? 0 : (dist > 113 ? 113 : dist);
                          float s = p0[r] + bt[idx]; s = (c <= cmax) ? s : MASKED; p0[r] = s; mx = fmaxf(mx, s); }
                        { const int c = c0 + 32 + ATT_OFF(r), dist = dd0 - 512 - 16 * ATT_OFF(r); const int idx = dist < 0 ? 0 : (dist > 113 ? 113 : dist);
                          float s = p1[r] + bt[idx]; s = (c <= cmax) ? s : MASKED; p1[r] = s; mx = fmaxf(mx, s); }
                    }
                } else {
                    const int d0 = t - (64 * j + 4 * hi);
                    const bool selb = (MODE == 0) ? (((selm >> j) & 1ull) != 0ull) : true;
#pragma unroll
                    for (int r = 0; r < 16; ++r) {
                        { const int dist = d0 - ATT_OFF(r); const int idx = dist < 0 ? 0 : (dist > 113 ? 113 : dist);
                          const bool valid = (MODE == 0) ? (dist >= 0 && selb) : (dist >= 0 && dist < WIN);
                          float s = p0[r] + bt[idx]; s = valid ? s : MASKED; p0[r] = s; mx = fmaxf(mx, s); }
                        { const int dist = d0 - 32 - ATT_OFF(r); const int idx = dist < 0 ? 0 : (dist > 113 ? 113 : dist);
                          const bool valid = (MODE == 0) ? (dist >= 0 && selb) : (dist >= 0 && dist < WIN);
                          float s = p1[r] + bt[idx]; s = valid ? s : MASKED; p1[r] = s; mx = fmaxf(mx, s); }
                    }
                }
                if (MODE != 2 || pass == 0) {
                    mx = fmaxf(mx, __shfl_xor(mx, 32));
                    const float mn = fmaxf(m, mx), alpha = __builtin_amdgcn_exp2f(m - mn); m = mn;
                    float ls = 0.f;
#pragma unroll
                    for (int r = 0; r < 16; ++r) { p0[r] = __builtin_amdgcn_exp2f(p0[r] - mn); p1[r] = __builtin_amdgcn_exp2f(p1[r] - mn); ls += p0[r] + p1[r]; }
                    l = l * alpha + ls;
                    if (MODE != 2) {
                        if (__any(alpha < 1.f)) {
#pragma unroll
                            for (int d = 0; d < 4; ++d)
#pragma unroll
                                for (int e = 0; e < 16; ++e) o[d][e] *= alpha;
                        }
                    }
                } else {
#pragma unroll
                    for (int r = 0; r < 16; ++r) { p0[r] = __builtin_amdgcn_exp2f(p0[r] - m) * invl; p1[r] = __builtin_amdgcn_exp2f(p1[r] - m) * invl; }
                    LAS float* imp = (LAS float*)(lds + IMP_OFF) + (size_t)((half * 4 + hh) * 64) * 33 + ql;
#pragma unroll
                    for (int k = 0; k < 4; ++k) {
                        const int jj0 = 16 * j + 2 * k + hi, jj1 = jj0 + 8;
                        const float G0 = (p0[4 * k] + p0[4 * k + 1]) + (p0[4 * k + 2] + p0[4 * k + 3]);
                        const float G1 = (p1[4 * k] + p1[4 * k + 1]) + (p1[4 * k + 2] + p1[4 * k + 3]);
                        LADD(imp + jj0 * 33, G0); LADD(imp + jj1 * 33, G1);
                        LADD(imp + (jj0 + 1) * 33, p0[4 * k + 3]);
                        if (jj1 + 1 < 64) LADD(imp + (jj1 + 1) * 33, p1[4 * k + 3]);
                    }
                }
                if (MODE != 2 || pass == 1) {
                    bf16x8 pf[4];
#pragma unroll
                    for (int s = 0; s < 4; ++s) {
                        const int rb = 8 * (s & 1);
                        unsigned w[4];
#pragma unroll
                        for (int e = 0; e < 4; ++e) w[e] = (s < 2) ? cvtpk(p0[rb + 2 * e], p0[rb + 2 * e + 1]) : cvtpk(p1[rb + 2 * e], p1[rb + 2 * e + 1]);
                        v4u wv; wv.x = w[0]; wv.y = w[1]; wv.z = w[2]; wv.w = w[3];
                        pf[s] = __builtin_bit_cast(bf16x8, wv);
                    }
                    pv_tile(o, (lcp)(lds + VB0 + cur * 16384), pf, lane);
                }
            }
            if (more) tile_store(lds, cur ^ 1, R, tid);
            __syncthreads();
        }
        if (MODE == 2 && pass == 0) { const float lt = l + __shfl_xor(l, 32); invl = lt > 0.f ? 1.f / lt : 0.f; }
    }
    if (MODE != 2) { const float lt = l + __shfl_xor(l, 32); invl = 1.f / lt; }
    {
        const size_t ob = row * 1024 + head * HD + 4 * hi;
        float g0 = 0.f, g1 = 0.f, g2 = 0.f;
        if (MODE == 0) { const float* gr = P.gates + row * 24 + head * 3; g0 = gr[0]; g1 = gr[1]; g2 = gr[2]; }
#pragma unroll
        for (int db = 0; db < 4; ++db)
#pragma unroll
            for (int k = 0; k < 4; ++k) {
                float v0 = o[db][4 * k], v1 = o[db][4 * k + 1], v2 = o[db][4 * k + 2], v3 = o[db][4 * k + 3];
                if (MODE != 2) { v0 *= invl; v1 *= invl; v2 *= invl; v3 *= invl; }
                const size_t off = ob + 32 * db + 8 * k;
                if (MODE == 0) {
                    const unsigned long long c8 = *(const GAS unsigned long long*)(P.OC + off), w8 = *(const GAS unsigned long long*)(P.OW + off);
                    float r0 = g0 * bf2f((unsigned short)c8) + g1 * v0; r0 = r0 + g2 * bf2f((unsigned short)w8);
                    float r1 = g0 * bf2f((unsigned short)(c8 >> 16)) + g1 * v1; r1 = r1 + g2 * bf2f((unsigned short)(w8 >> 16));
                    float r2 = g0 * bf2f((unsigned short)(c8 >> 32)) + g1 * v2; r2 = r2 + g2 * bf2f((unsigned short)(w8 >> 32));
                    float r3 = g0 * bf2f((unsigned short)(c8 >> 48)) + g1 * v3; r3 = r3 + g2 * bf2f((unsigned short)(w8 >> 48));
                    *(GAS unsigned long long*)(P.AO + row * 2048 + head * HD + 4 * hi + 32 * db + 8 * k) = (unsigned long long)cvtpk(r0, r1) | ((unsigned long long)cvtpk(r2, r3) << 32);
                } else {
                    bf16* dst = (MODE == 1 ? P.OW : P.OC) + off;
                    *(GAS unsigned long long*)dst = (unsigned long long)cvtpk(v0, v1) | ((unsigned long long)cvtpk(v2, v3) << 32);
                }
            }
    }
    if (MODE == 2) {
        __syncthreads();
        const LAS float* impb = (const LAS float*)(lds + IMP_OFF);
#pragma unroll 1
        for (int qi = 0; qi < 8; ++qi) {
            const int qidx = wave * 8 + qi, hf = qidx >> 5, q_ = qidx & 31, tt = (hf ? qB0 : qA0) + q_, cur = tt >> 6, jj = lane;
            float v = 0.f;
#pragma unroll
            for (int h_ = 0; h_ < 4; ++h_) v += impb[((hf * 4 + h_) * 64 + jj) * 33 + q_];
            if (jj == 0 || jj == cur || jj == cur - 1) v = FORCEV;
            if (jj * 64 > tt) v = NEGV;
            int rank = 0;
#pragma unroll 1
            for (int i = 0; i < 64; ++i) { const float vi = __builtin_bit_cast(float, __builtin_amdgcn_readlane(__builtin_bit_cast(int, v), i)); rank += (vi > v || (vi == v && i < jj)) ? 1 : 0; }
            const unsigned long long mk = __ballot(rank < TOPK);
            if (lane == 0) P.selm_out[(size_t)bg * T_ + tt] = mk;
        }
    }
    __syncthreads();
}
}

struct Args { const float* in[16]; float* out; unsigned char* ws; int ph_lo, ph_hi, li, pad; };

__global__ void __launch_bounds__(NWAVES * 64, 2) mega_fwd(Args args) {
    extern __shared__ __attribute__((aligned(16))) unsigned char lds_raw[];
    LAS unsigned char* lds = (LAS unsigned char*)lds_raw;
    volatile LAS unsigned* MISC = (volatile LAS unsigned*)(lds + MISC_OFF);
    const int tid = threadIdx.x, lane = tid & 63, wave = __builtin_amdgcn_readfirstlane(tid >> 6);
    const int G = gridDim.x; const int bx = blockIdx.x;
    const int vcu = (G % 8 == 0) ? (bx % 8) * (G / 8) + bx / 8 : bx;
    unsigned char* ws = args.ws;
    const float* x = args.in[0]; const float* w_in = args.in[1]; const float* pe = args.in[2];
    const float* wk1 = args.in[3]; const float* wk2 = args.in[4]; const float* wv1 = args.in[5]; const float* wv2 = args.in[6];
    const float* conv_w = args.in[7]; const float* w_o = args.in[9]; const float* w_up = args.in[10]; const float* w_down = args.in[11];
    const float* g_pre_mix = args.in[12]; const float* g_post_mix = args.in[13]; const float* g_pre_ffn = args.in[14]; const float* g_post_ffn = args.in[15];
    float* out = args.out;
    bf16* WinT = (bf16*)(ws + WS_WIN); bf16* WoT = (bf16*)(ws + WS_WO); bf16* WupT = (bf16*)(ws + WS_WUP); bf16* WdnT = (bf16*)(ws + WS_WDN);
    bf16* W1T = (bf16*)(ws + WS_W1); bf16* Hb = (bf16*)(ws + WS_H); bf16* Qb = (bf16*)(ws + WS_Q); bf16* KVb = (bf16*)(ws + WS_KV);
    bf16* C3b = (bf16*)(ws + WS_C3); bf16* Ub = (bf16*)(ws + WS_U); float* Fb = (float*)(ws + WS_F); float* SLAB = (float*)(ws + WS_SLAB);
    const float* rel_bias = args.in[8]; unsigned long long* SELM = (unsigned long long*)(ws + WS_SELM); bf16* OCb = (bf16*)(ws + WS_OC); bf16* OWb = (bf16*)(ws + WS_OW);
    float* PEB = (float*)(ws + WS_PEB); float* GATES = (float*)(ws + WS_GATES); bf16* KCMP = (bf16*)(ws + WS_KCMP); bf16* VCMP = (bf16*)(ws + WS_VCMP);

    for (int u = tid; u < (LDS_BYTES - LDSCTL_OFF) / 4; u += NWAVES * 64) ((LAS unsigned*)(lds + LDSCTL_OFF))[u] = 0u;
    __syncthreads();
    XcdBarrier bar = xcd_barrier_post((unsigned*)(ws + WS_CTL) + 1024 + args.li * 4096, MISC + 8);
    const int lo = args.ph_lo, hi = args.ph_hi;
#define IN(k) (lo <= (k) && (k) < hi)
#define BOTH(k) (IN(k) && IN((k) + 1))
    const int gw = vcu * NWAVES + wave, NGW = G * NWAVES;

    if (IN(0)) {
        LAS float* scr = (LAS float*)(lds + wave * 16384);
        constexpr int I_IN = 32 * (NQT / 32), I_O = 32 * 64, I_UP = 32 * 256, I_DN = 128 * 64, I_C1 = 64 * 8;
        constexpr int NITEMS = I_IN + I_O + I_UP + I_DN + 2 * I_C1;
        for (int it = gw; it < NITEMS; it += NGW) {
            int r = it;
            if (r < I_IN) { p0_transpose_item(w_in, INW, D_, NQT / 32, WinT, scr, r, lane, true); continue; } r -= I_IN;
            if (r < I_O) { p0_transpose_item(w_o, D_, 2048, 64, WoT, scr, r, lane, false); continue; } r -= I_O;
            if (r < I_UP) { p0_transpose_item(w_up, DFF, D_, 256, WupT, scr, r, lane, false); continue; } r -= I_UP;
            if (r < I_DN) { p0_transpose_item(w_down, D_, DFF, 64, WdnT, scr, r, lane, false); continue; } r -= I_DN;
            if (r < I_C1) { p0_transpose_item(wk1, 256, 4096, 8, W1T, scr, r, lane, false); continue; } r -= I_C1;
            p0_transpose_item(wv1, 256, 4096, 8, W1T + (size_t)256 * 4096, scr, r, lane, false);
        }
        for (int m = gw; m < M_; m += NGW) rms_row_to_bf16(x + (size_t)m * D_, g_pre_mix, Hb + (size_t)m * D_, lane);
        for (int it = gw; it < 256; it += NGW) {
            const int kv = it >> 7, ch = (it >> 2) & 31, hg = it & 3; const float* w1 = kv ? wv1 : wk1;
            float s = 0.f;
            for (int k = ch * 128; k < ch * 128 + 128; ++k) s += pe[k] * w1[(size_t)k * 256 + hg * 64 + lane];
            PEB[(kv * 32 + ch) * 256 + hg * 64 + lane] = s;
        }
        if (BOTH(0)) xcd_barrier(bar);
    }

    if (IN(1)) {
        pg8::Gemm g{Hb, WinT, M_, NQT, D_, D_, D_}; pg8::StaticOrder S; S.init(M_, NQT, G, bx);
        pg8::EpiInProj E{Qb, KVb, C3b, GATES, QSCALE};
        pg8::gemm_phase<pg8::EpiInProj, pg8::StaticOrder, true, true>(lds, g, S, E);
        if (BOTH(1)) xcd_barrier(bar);
    }

    if (IN(2)) {
        {
            const bool has = vcu < 64; const int kv = (vcu >> 5) & 1, ch = (vcu >> 2) & 7, pm = vcu & 3;
            pg8::Gemm g{KVb + (size_t)kv * KVSZ + ch * 512, W1T + (size_t)kv * 256 * 4096 + ch * 512, 1024, 256, 512, 2048, 4096};
            pg8::OneUnit S{has, {pm, 0}};
            pg8::EpiF32 E{SLAB + (size_t)(kv * 8 + ch) * 1024 * 256, 256};
            pg8::gemm_phase<pg8::EpiF32, pg8::OneUnit, false, true>(lds, g, S, E);
        }
        {
            const bf16* CH = C3b; const bf16* CB = C3b + (size_t)M_ * 1024; const bf16* CC = C3b + (size_t)2 * M_ * 1024;
            for (int idx = vcu * 512 + tid; idx < M_ * 128; idx += G * 512) {
                const int r = idx >> 7, c8 = (idx & 127) * 8, t = r & 4095; const size_t o = (size_t)r * 1024 + c8;
                const v4u h2 = *(const GAS v4u*)(CH + o), c2 = *(const GAS v4u*)(CC + o), bb = *(const GAS v4u*)(CB + o);
                v4u h1 = {0, 0, 0, 0}, c1 = {0, 0, 0, 0}, h0 = {0, 0, 0, 0}, c0 = {0, 0, 0, 0};
                if (t >= 1) { h1 = *(const GAS v4u*)(CH + o - 1024); c1 = *(const GAS v4u*)(CC + o - 1024); }
                if (t >= 2) { h0 = *(const GAS v4u*)(CH + o - 2048); c0 = *(const GAS v4u*)(CC + o - 2048); }
                unsigned ow[4];
#pragma unroll
                for (int e = 0; e < 4; ++e) {
                    float res[2];
#pragma unroll
                    for (int p = 0; p < 2; ++p) {
                        const int sh = 16 * p; const int col = c8 + 2 * e + p;
                        const float u2 = bf2f((unsigned short)(c2[e] >> sh)) * bf2f((unsigned short)(h2[e] >> sh));
                        const float u1 = bf2f((unsigned short)(c1[e] >> sh)) * bf2f((unsigned short)(h1[e] >> sh));
                        const float u0 = bf2f((unsigned short)(c0[e] >> sh)) * bf2f((unsigned short)(h0[e] >> sh));
                        float y = conv_w[col] * u0; y = y + conv_w[1024 + col] * u1; y = y + conv_w[2048 + col] * u2;
                        res[p] = bf2f((unsigned short)(bb[e] >> sh)) * y;
                    }
                    ow[e] = pk2(res[0], res[1]);
                }
                v4u ov; ov.x = ow[0]; ov.y = ow[1]; ov.z = ow[2]; ov.w = ow[3];
                *(GAS v4u*)(Hb + (size_t)r * 2048 + 1024 + c8) = ov;
            }
        }
        {
            att::AttnBufs P{Qb, KVb + 4 * KVSZ, KVb + 5 * KVSZ, T_, rel_bias, SELM, SELM, GATES, OCb, OWb, Hb};
            for (int it = vcu; it < 256; it += G) { const int bg = it >> 6, qb = it & 63; att::attn_item<1>(lds, P, bg >> 1, bg & 1, 64 * qb, 64 * qb + 32, tid, lane, wave); }
        }
        if (BOTH(2)) xcd_barrier(bar);
    }

    if (IN(3)) {
        LAS float* hid = (LAS float*)lds;
        for (int it = vcu; it < 64; it += G) {
            const int kv = it >> 5, bg = (it >> 3) & 3, sl = it & 7, r0 = bg * 256 + sl * 32;
            const float* w2 = kv ? wv2 : wk2; bf16* outp = kv ? VCMP : KCMP;
            {
                const int h = tid & 255; float pb = 0.f;
                for (int c2 = 0; c2 < 32; ++c2) pb += PEB[(kv * 32 + c2) * 256 + h];
                for (int e = tid; e < 32 * 256; e += 512) { const int r = e >> 8; float s = 0.f;
                    for (int ch = 0; ch < 8; ++ch) s += SLAB[((size_t)(kv * 8 + ch) * 1024 + r0 + r) * 256 + h];
                    s += pb; hid[e] = s / (1.f + __expf(-s)); }
            }
            __syncthreads();
            {
                const int e = tid & 127, rg = tid >> 7; float acc[8];
#pragma unroll
                for (int i = 0; i < 8; ++i) acc[i] = 0.f;
                for (int h = 0; h < 256; ++h) { const float w = w2[h * 128 + e];
#pragma unroll
                    for (int i = 0; i < 8; ++i) acc[i] += hid[(rg * 8 + i) * 256 + h] * w; }
#pragma unroll
                for (int i = 0; i < 8; ++i) { const int c = sl * 32 + rg * 8 + i; outp[((size_t)bg * 256 + c) * 128 + e] = (c < NCMP) ? (bf16)f2bf(acc[i]) : (bf16)0; }
            }
            __syncthreads();
        }
        if (BOTH(3)) xcd_barrier(bar);
    }

    if (IN(4)) {
        att::AttnBufs P{Qb, KCMP, VCMP, 256, rel_bias, SELM, SELM, GATES, OCb, OWb, Hb};
        for (int it = vcu; it < 256; it += G) { const int bg = it >> 6, qb = it & 63; att::attn_item<2>(lds, P, bg >> 1, bg & 1, 64 * qb, 64 * qb + 32, tid, lane, wave); }
        if (BOTH(4)) xcd_barrier(bar);
    }
    if (IN(5)) {
        att::AttnBufs P{Qb, KVb + 2 * KVSZ, KVb + 3 * KVSZ, T_, rel_bias, SELM, SELM, GATES, OCb, OWb, Hb};
        for (int it = vcu; it < 256; it += G) { const int bg = it >> 6, pp = it & 63; att::attn_item<0>(lds, P, bg >> 1, bg & 1, 32 * pp, 32 * (127 - pp), tid, lane, wave); }
        if (BOTH(5)) xcd_barrier(bar);
    }

    if (IN(6)) {
        pg8::Gemm g{Hb, WoT, M_, D_, 2048, 2048, 2048}; pg8::StaticOrder S; S.init(M_, D_, G, bx);
        pg8::EpiF32 E{out, D_};
        pg8::gemm_phase<pg8::EpiF32, pg8::StaticOrder, true, true>(lds, g, S, E);
        if (BOTH(6)) xcd_barrier(bar);
    }

    if (IN(7)) {
        for (int m = gw; m < M_; m += NGW) {
            GAS f32x4* mr = (GAS f32x4*)(out + (size_t)m * D_) + lane; const GAS f32x4* xr = (const GAS f32x4*)(x + (size_t)m * D_) + lane;
            const GAS f32x4* g1 = (const GAS f32x4*)g_post_mix + lane; const GAS f32x4* g2 = (const GAS f32x4*)g_pre_ffn + lane;
            f32x4 v[8]; float s = 0.f;
#pragma unroll
            for (int j = 0; j < 8; ++j) { v[j] = mr[64 * j]; s += (v[j].x * v[j].x + v[j].y * v[j].y) + (v[j].z * v[j].z + v[j].w * v[j].w); }
            const float r1 = rsqrtf(wave_sum(s) * (1.f / D_) + EPS); float s2 = 0.f;
#pragma unroll
            for (int j = 0; j < 8; ++j) { const f32x4 g = g1[64 * j], xx = xr[64 * j];
                v[j].x = xx.x + (v[j].x * r1) * g.x; v[j].y = xx.y + (v[j].y * r1) * g.y; v[j].z = xx.z + (v[j].z * r1) * g.z; v[j].w = xx.w + (v[j].w * r1) * g.w;
                mr[64 * j] = v[j]; s2 += (v[j].x * v[j].x + v[j].y * v[j].y) + (v[j].z * v[j].z + v[j].w * v[j].w); }
            const float r2 = rsqrtf(wave_sum(s2) * (1.f / D_) + EPS);
            GAS unsigned long long* o8 = (GAS unsigned long long*)(Hb + (size_t)m * D_) + lane;
#pragma unroll
            for (int j = 0; j < 8; ++j) { const f32x4 g = g2[64 * j];
                o8[64 * j] = (unsigned long long)pk2((v[j].x * r2) * g.x, (v[j].y * r2) * g.y) | ((unsigned long long)pk2((v[j].z * r2) * g.z, (v[j].w * r2) * g.w) << 32); }
        }
        if (BOTH(7)) xcd_barrier(bar);
    }

    if (IN(8)) {
        pg8::Gemm g{Hb, WupT, M_, DFF, D_, D_, D_}; pg8::StaticOrder S; S.init(M_, DFF, G, bx);
        pg8::EpiRelu2Bf16 E{Ub, DFF};
        pg8::gemm_phase<pg8::EpiRelu2Bf16, pg8::StaticOrder, true, true>(lds, g, S, E);
        if (BOTH(8)) xcd_barrier(bar);
    }

    if (IN(9)) {
        pg8::Gemm g{Ub, WdnT, M_, D_, DFF, DFF, DFF}; pg8::StaticOrder S; S.init(M_, D_, G, bx);
        pg8::EpiF32 E{Fb, D_};
        pg8::gemm_phase<pg8::EpiF32, pg8::StaticOrder, true, true>(lds, g, S, E);
        if (BOTH(9)) xcd_barrier(bar);
    }

    if (IN(10)) {
        for (int m = gw; m < M_; m += NGW) {
            const GAS f32x4* fr = (const GAS f32x4*)(Fb + (size_t)m * D_) + lane; GAS f32x4* orow = (GAS f32x4*)(out + (size_t)m * D_) + lane;
            const GAS f32x4* g1 = (const GAS f32x4*)g_post_ffn + lane;
            f32x4 v[8]; float s = 0.f;
#pragma unroll
            for (int j = 0; j < 8; ++j) { v[j] = fr[64 * j]; s += (v[j].x * v[j].x + v[j].y * v[j].y) + (v[j].z * v[j].z + v[j].w * v[j].w); }
            const float r1 = rsqrtf(wave_sum(s) * (1.f / D_) + EPS);
#pragma unroll
            for (int j = 0; j < 8; ++j) { const f32x4 g = g1[64 * j]; f32x4 xx = orow[64 * j];
                xx.x = xx.x + (v[j].x * r1) * g.x; xx.y = xx.y + (v[j].y * r1) * g.y; xx.z = xx.z + (v[j].z * r1) * g.z; xx.w = xx.w + (v[j].w * r1) * g.w;
                orow[64 * j] = xx; }
        }
    }
#undef IN
#undef BOTH
}

__device__ __forceinline__ float block_max(float v, float* red) {
  for (int o = 32; o > 0; o >>= 1) v = fmaxf(v, __shfl_xor(v, o));
  __syncthreads();
  if ((threadIdx.x & 63) == 0) red[threadIdx.x >> 6] = v;
  __syncthreads();
  return fmaxf(fmaxf(red[0], red[1]), fmaxf(red[2], red[3]));
}
__device__ __forceinline__ float block_sum(float v, float* red) {
  for (int o = 32; o > 0; o >>= 1) v += __shfl_xor(v, o);
  __syncthreads();
  if ((threadIdx.x & 63) == 0) red[threadIdx.x >> 6] = v;
  __syncthreads();
  return (red[0] + red[1]) + (red[2] + red[3]);
}
__global__ __launch_bounds__(256) void cmp_attn_ref(const bf16* Qb, const bf16* KCMP, const bf16* VCMP, const float* rel_bias, bf16* OC, unsigned long long* selmask) {
  const int id = blockIdx.x, t = id % T_, g = (id / T_) % NKV, b = id / (T_ * NKV);
  const int tid = threadIdx.x;
  const size_t row = (size_t)b * T_ + t;
  __shared__ float q[4][HD];
  __shared__ float p[4][256];
  __shared__ float red[4];
  for (int i = tid; i < 512; i += 256) q[i >> 7][i & 127] = bf2f(Qb[row * 1024 + (g * 4 + (i >> 7)) * HD + (i & 127)]);
  __syncthreads();
  const int c = tid;
  const bool valid = (c < NCMP) && (16 * c + 31 <= t);
  float s[4] = {NEGV, NEGV, NEGV, NEGV};
  if (valid) {
    const int bk = rel_bucket(t - (16 * c + 31));
    const bf16* kr = KCMP + ((size_t)(b * NKV + g) * 256 + c) * HD;
    float a0 = 0.f, a1 = 0.f, a2 = 0.f, a3 = 0.f;
    for (int d = 0; d < HD; ++d) { const float kvv = bf2f(kr[d]); a0 += q[0][d] * kvv; a1 += q[1][d] * kvv; a2 += q[2][d] * kvv; a3 += q[3][d] * kvv; }
    s[0] = a0 + rel_bias[(g * 4 + 0) * 32 + bk] * LOG2E;
    s[1] = a1 + rel_bias[(g * 4 + 1) * 32 + bk] * LOG2E;
    s[2] = a2 + rel_bias[(g * 4 + 2) * 32 + bk] * LOG2E;
    s[3] = a3 + rel_bias[(g * 4 + 3) * 32 + bk] * LOG2E;
  }
#pragma unroll
  for (int h = 0; h < 4; ++h) {
    const float m = block_max(s[h], red);
    const float e = valid ? exp2f(s[h] - m) : 0.f;
    const float l = block_sum(e, red);
    p[h][c] = valid ? e / l : 0.f;
  }
  __syncthreads();
  {
    const int d = tid & 127, hp = tid >> 7;
    const bf16* vb = VCMP + (size_t)(b * NKV + g) * 256 * HD;
    float o0 = 0.f, o1 = 0.f;
    for (int cc = 0; cc < NCMP; ++cc) { const float vv = bf2f(vb[cc * HD + d]); o0 += p[hp * 2][cc] * vv; o1 += p[hp * 2 + 1][cc] * vv; }
    const int h0 = g * 4 + hp * 2;
    OC[row * 1024 + h0 * HD + d] = (bf16)f2bf(o0);
    OC[row * 1024 + (h0 + 1) * HD + d] = (bf16)f2bf(o1);
  }
  if (tid < 64) {
    const int j = tid, cur = t >> 6;
    float v = 0.f;
    for (int h = 0; h < 4; ++h)
      for (int cc = 4 * j - 1; cc <= 4 * j + 3; ++cc)
        if (cc >= 0 && cc < NCMP) v += p[h][cc];
    if (j == 0 || j == cur || j == cur - 1) v = FORCEV;
    if (j * 64 > t) v = NEGV;
    int rank = 0;
    for (int i = 0; i < 64; ++i) { const float vi = __shfl(v, i); rank += (vi > v || (vi == v && i < j)) ? 1 : 0; }
    const unsigned long long mk = __ballot(rank < TOPK);
    if (tid == 0) selmask[(size_t)(b * NKV + g) * T_ + t] = mk;
  }
}
template <int MODE>
__global__ __launch_bounds__(256) void attn_ref(const bf16* Qb, const bf16* KVb, const float* rel_bias, const unsigned long long* selmask, const float* GATES,
                                                const bf16* OC, bf16* OW, bf16* AO, int ao_ld) {
  const int id = blockIdx.x, t = id % T_, g = (id / T_) % NKV, b = id / (T_ * NKV);
  const int tid = threadIdx.x;
  const size_t row = (size_t)b * T_ + t;
  __shared__ float q[4][HD];
  __shared__ float sc[4][1024];
  __shared__ float red[4];
  __shared__ int blist[16];
  __shared__ int nblk;
  const bf16* Kb = KVb + (size_t)(MODE ? 4 : 2) * KVSZ + (size_t)(b * NKV + g) * T_ * HD;
  const bf16* Vb = KVb + (size_t)(MODE ? 5 : 3) * KVSZ + (size_t)(b * NKV + g) * T_ * HD;
  for (int i = tid; i < 512; i += 256) q[i >> 7][i & 127] = bf2f(Qb[row * 1024 + (g * 4 + (i >> 7)) * HD + (i & 127)]);
  if (MODE == 0 && tid == 0) {
    const unsigned long long mk = selmask[(size_t)(b * NKV + g) * T_ + t];
    int n = 0;
    for (int j = 0; j < NSEL; ++j) if (((mk >> j) & 1ull) && j * 64 <= t && n < 16) blist[n++] = j;
    nblk = n;
  }
  __syncthreads();
  const int kstart = t - (WIN - 1) < 0 ? 0 : t - (WIN - 1);
  const int nkeys = MODE ? (t - kstart + 1) : nblk * 64;
  for (int i = tid; i < nkeys; i += 256) {
    const int pos = MODE ? (kstart + i) : (blist[i >> 6] * 64 + (i & 63));
    const bool valid = pos <= t;
    float s0 = NEGV, s1 = NEGV, s2 = NEGV, s3 = NEGV;
    if (valid) {
      const bf16* kr = Kb + (size_t)pos * HD;
      float a0 = 0.f, a1 = 0.f, a2 = 0.f, a3 = 0.f;
      for (int d = 0; d < HD; ++d) { const float kvv = bf2f(kr[d]); a0 += q[0][d] * kvv; a1 += q[1][d] * kvv; a2 += q[2][d] * kvv; a3 += q[3][d] * kvv; }
      const int bk = rel_bucket(t - pos);
      s0 = a0 + rel_bias[(g * 4 + 0) * 32 + bk] * LOG2E;
      s1 = a1 + rel_bias[(g * 4 + 1) * 32 + bk] * LOG2E;
      s2 = a2 + rel_bias[(g * 4 + 2) * 32 + bk] * LOG2E;
      s3 = a3 + rel_bias[(g * 4 + 3) * 32 + bk] * LOG2E;
    }
    sc[0][i] = s0; sc[1][i] = s1; sc[2][i] = s2; sc[3][i] = s3;
  }
  __syncthreads();
#pragma unroll
  for (int h = 0; h < 4; ++h) {
    float m = NEGV;
    for (int i = tid; i < nkeys; i += 256) m = fmaxf(m, sc[h][i]);
    m = block_max(m, red);
    float l = 0.f;
    for (int i = tid; i < nkeys; i += 256) { const float sv = sc[h][i]; const float e = (sv > -1e29f) ? exp2f(sv - m) : 0.f; sc[h][i] = e; l += e; }
    l = block_sum(l, red);
    const float inv = 1.f / l;
    for (int i = tid; i < nkeys; i += 256) sc[h][i] *= inv;
  }
  __syncthreads();
  {
    const int d = tid & 127, hp = tid >> 7;
    float o0 = 0.f, o1 = 0.f;
    for (int i = 0; i < nkeys; ++i) {
      const int pos = MODE ? (kstart + i) : (blist[i >> 6] * 64 + (i & 63));
      if (pos <= t) { const float vv = bf2f(Vb[(size_t)pos * HD + d]); o0 += sc[hp * 2][i] * vv; o1 += sc[hp * 2 + 1][i] * vv; }
    }
    const int h0 = g * 4 + hp * 2;
    const size_t i0 = row * 1024 + h0 * HD + d, i1 = row * 1024 + (h0 + 1) * HD + d;
    if (MODE) { OW[i0] = (bf16)f2bf(o0); OW[i1] = (bf16)f2bf(o1); }
    else {
      const float* gr = GATES + row * 24;
      float r0 = gr[h0 * 3 + 0] * bf2f(OC[i0]) + gr[h0 * 3 + 1] * o0; r0 = r0 + gr[h0 * 3 + 2] * bf2f(OW[i0]);
      float r1 = gr[(h0 + 1) * 3 + 0] * bf2f(OC[i1]) + gr[(h0 + 1) * 3 + 1] * o1; r1 = r1 + gr[(h0 + 1) * 3 + 2] * bf2f(OW[i1]);
      AO[row * ao_ld + h0 * HD + d] = (bf16)f2bf(r0);
      AO[row * ao_ld + (h0 + 1) * HD + d] = (bf16)f2bf(r1);
    }
  }
}

static void launch_mega(const Args& a0, int lo, int hi, int li, int grid, hipStream_t stream) {
    Args a = a0; a.ph_lo = lo; a.ph_hi = hi; a.li = li; a.pad = 0;
    void* params[] = {&a};
    hipError_t e = hipLaunchCooperativeKernel((const void*)mega_fwd, dim3(grid), dim3(NWAVES * 64), params, LDS_BYTES, stream);
    if (e != hipSuccess) fprintf(stderr, "kernel_launch: cooperative launch failed: %s (grid %d)\n", hipGetErrorString(e), grid);
}


#ifndef DEBUG_CHECK
#define DEBUG_CHECK 0
#endif
#if DEBUG_CHECK
__global__ void cmp_bf16_k(const bf16* a, int lda, const bf16* b, int ldb, int rows, int cols, unsigned* maxerr) {
    float e = 0.f;
    for (size_t i = (size_t)blockIdx.x * blockDim.x + threadIdx.x; i < (size_t)rows * cols; i += (size_t)gridDim.x * blockDim.x) {
        const int r = (int)(i / cols), c = (int)(i % cols);
        const float d = fabsf(bf2f(a[(size_t)r * lda + c]) - bf2f(b[(size_t)r * ldb + c]));
        e = fmaxf(e, d == d ? d : 1e9f);
    }
    for (int o = 32; o > 0; o >>= 1) e = fmaxf(e, __shfl_xor(e, o));
    if ((threadIdx.x & 63) == 0) atomicMax(maxerr, __float_as_uint(e));
}
__global__ void cmp_mask_k(const unsigned long long* a, const unsigned long long* b, int n, unsigned* cnt) {
    const int i = blockIdx.x * blockDim.x + threadIdx.x;
    if (i < n) { const int t = i & 4095; const int cur = t >> 6; const unsigned long long causal = cur >= 63 ? ~0ull : ((1ull << (cur + 1)) - 1ull);
        if ((a[i] & causal) != (b[i] & causal)) atomicAdd(cnt, 1u); }
}
__global__ void flag_k(const unsigned* errs, float* out) {
    if (threadIdx.x == 0 && blockIdx.x == 0) {
        const float e1 = __uint_as_float(errs[0]), e2 = __uint_as_float(errs[1]), e4 = __uint_as_float(errs[3]); const unsigned n3 = errs[2];
        float code = 0.f, sev = 0.f; const float tol = 0.01f;
        if (e1 > tol) { code = 1.f; sev = e1 / tol; }
        else if (e2 > tol) { code = 2.f; sev = e2 / tol; }
        else if (n3 > 16u) { code = 3.f; sev = (float)n3 / 16.f; }
        else if (e4 > tol) { code = 4.f; sev = e4 / tol; }
        if (code > 0.f) { sev = sev > 9.f ? 9.f : sev; out[0] += 100.f * code + 10.f * floorf(sev); }
#if DEBUG_CHECK == 2
        out[0] += 1e4f * fmaxf(e1, fmaxf(e2, e4)); out[1] += (float)n3;
#endif
    }
}
#endif

extern "C" void kernel_launch(void* const* d_in, const int* in_sizes, int n_in, void* d_out, int out_size, void* d_ws, size_t ws_size, hipStream_t stream) {
    static int grid = 0;
    if (grid == 0) {
        if (n_in != 16 || ws_size < WS_END) { fprintf(stderr, "kernel_launch: unexpected n_in %d or ws_size %zu (< %zu)\n", n_in, ws_size, (size_t)WS_END); grid = -1; return; }
        int dev = 0, cus = 0, per_cu = 0;
        (void)hipGetDevice(&dev); (void)hipDeviceGetAttribute(&cus, hipDeviceAttributeMultiprocessorCount, dev);
        (void)hipFuncSetAttribute((const void*)mega_fwd, hipFuncAttributeMaxDynamicSharedMemorySize, LDS_BYTES);
        (void)hipOccupancyMaxActiveBlocksPerMultiprocessor(&per_cu, (const void*)mega_fwd, NWAVES * 64, LDS_BYTES);
        if (per_cu < 1) { fprintf(stderr, "kernel_launch: occupancy query says %d blocks per CU\n", per_cu); grid = -1; return; }
        grid = cus;
    }
    if (grid < 0) return;
    (void)hipMemsetAsync((char*)d_ws + WS_CTL, 0, CTL_ZERO_BYTES, stream);
    Args a{};
    for (int i = 0; i < 16; ++i) a.in[i] = (const float*)d_in[i];
    a.out = (float*)d_out; a.ws = (unsigned char*)d_ws;
#if DEBUG_CHECK
    unsigned char* ws = (unsigned char*)d_ws;
    const float* rel_bias = (const float*)d_in[8];
    unsigned* errs = (unsigned*)(ws + WS_CTL + 122880);
    bf16* TMP = (bf16*)(ws + WS_WIN);
    unsigned long long* SELMX = (unsigned long long*)(ws + WS_WIN + 20 * MiB);
    launch_mega(a, 0, 4, 0, grid, stream);
    attn_ref<1><<<B_ * NKV * T_, 256, 0, stream>>>((const bf16*)(ws + WS_Q), (const bf16*)(ws + WS_KV), rel_bias, (const unsigned long long*)(ws + WS_SELM),
                                                   (const float*)(ws + WS_GATES), (const bf16*)(ws + WS_OC), TMP, TMP, 1024);
    cmp_bf16_k<<<1024, 256, 0, stream>>>((const bf16*)(ws + WS_OW), 1024, TMP, 1024, M_, 1024, errs + 0);
    launch_mega(a, 4, 5, 1, grid, stream);
    cmp_attn_ref<<<B_ * NKV * T_, 256, 0, stream>>>((const bf16*)(ws + WS_Q), (const bf16*)(ws + WS_KCMP), (const bf16*)(ws + WS_VCMP), rel_bias, TMP, SELMX);
    cmp_bf16_k<<<1024, 256, 0, stream>>>((const bf16*)(ws + WS_OC), 1024, TMP, 1024, M_, 1024, errs + 1);
    cmp_mask_k<<<64, 256, 0, stream>>>((const unsigned long long*)(ws + WS_SELM), SELMX, 4 * T_, errs + 2);
    launch_mega(a, 5, 6, 2, grid, stream);
    attn_ref<0><<<B_ * NKV * T_, 256, 0, stream>>>((const bf16*)(ws + WS_Q), (const bf16*)(ws + WS_KV), rel_bias, (const unsigned long long*)(ws + WS_SELM),
                                                   (const float*)(ws + WS_GATES), (const bf16*)(ws + WS_OC), (bf16*)(ws + WS_OW), TMP, 1024);
    cmp_bf16_k<<<1024, 256, 0, stream>>>((const bf16*)(ws + WS_H), 2048, TMP, 1024, M_, 1024, errs + 3);
    launch_mega(a, 6, 11, 3, grid, stream);
    flag_k<<<1, 64, 0, stream>>>(errs, (float*)d_out);
#else
    launch_mega(a, 0, 11, 0, grid, stream);
#endif
}
```

```cpp
#include <hip/hip_runtime.h>
#include <cstdio>
#include <cstdint>
namespace pg8 {
#define PG8_LAS __attribute__((address_space(3)))
typedef unsigned short bf16_t;
typedef short bf16x8 __attribute__((ext_vector_type(8)));
typedef float f32x4 __attribute__((ext_vector_type(4)));
typedef unsigned u32x4 __attribute__((ext_vector_type(4)));
constexpr int BM = 256, BK = 64, HALF = 128, HTB = HALF * BK * 2  , STAGE_BYTES = 8 * HTB, NXCD = 8, WGM = 8;

__host__ __device__ __forceinline__ int lds_byte(int r, int c) { const int st = (r >> 4) * 2 + (c >> 5), rr = r & 15, cc = c & 31, ob = rr * 64 + cc * 2; return st * 1024 + (ob ^ (((ob >> 9) & 1) << 5)); }
__host__ __device__ __forceinline__ void stage_rc(int b, int& R, int& C) { const int st = b / 1024, sb = b % 1024, swz = sb ^ (((sb >> 9) & 1) << 5); R = (st >> 1) * 16 + swz / 64; C = (st & 1) * 32 + (swz % 64) / 2; }
__host__ __device__ __forceinline__ int perm32(int rho) { const int n = rho >> 4, i = rho & 15; return 8 * (i >> 2) + 4 * n + (i & 3); }

struct Unit { int pm, pn; };
struct Gemm { const bf16_t* A; const bf16_t* Bt; int M, N, K, lda, ldb; };

struct StaticOrder {
    int nM, nN, nwg, G, c;
    __host__ __device__ void init(int M, int N, int G_, int c_) { nM = M / BM; nN = N / BM; nwg = nM * nN; G = G_; c = c_; }
    __host__ __device__ bool next(int i, Unit& u) const {
        const long L = (long)i * G + c; if (L >= nwg) return false;
        int wgid = (int)L; { const int q = nwg / NXCD, r = nwg % NXCD, xcd = wgid % NXCD, off = wgid / NXCD; wgid = (xcd < r ? xcd * (q + 1) : r * (q + 1) + (xcd - r) * q) + off; }
        const int nig = WGM * nN, gid = wgid / nig, fm = gid * WGM, gsz = (nM - fm) < WGM ? (nM - fm) : WGM;
        u.pm = fm + ((wgid % nig) % gsz); u.pn = (wgid % nig) / gsz; return true;
    }
    __device__ __forceinline__ void a_ready(const Unit&) const {}
    __device__ __forceinline__ void done(const Unit&) const {}
};

__device__ __forceinline__ unsigned cvt_pk_bf16(float lo, float hi) { unsigned r; asm volatile("v_cvt_pk_bf16_f32 %0, %1, %2" : "=v"(r) : "v"(lo), "v"(hi)); return r; }
typedef float f32x2 __attribute__((ext_vector_type(2)));
struct EpiF32 {
    static constexpr bool PERM = false, AFTER_DRAIN = false;
    float* C; int ldc;
    __device__ __forceinline__ void operator()(const f32x4 (&acc)[2][2][4][2], const Unit& u, int wr, int wc, int fr, int fq) const {
        const int row0 = u.pm * BM + wr * 64 + fr, col0 = u.pn * BM + wc * 32 + 4 * fq;
#pragma unroll
        for (int ai = 0; ai < 2; ++ai)
#pragma unroll
            for (int m = 0; m < 4; ++m) { float* rowp = C + (size_t)(row0 + ai * HALF + m * 16) * ldc + col0;
#pragma unroll
                for (int bj = 0; bj < 2; ++bj)
#pragma unroll
                    for (int n = 0; n < 2; ++n) *(f32x4*)(rowp + bj * HALF + n * 16) = acc[ai][bj][m][n]; }
    }
};
struct EpiRelu2Bf16 {
    static constexpr bool PERM = true, AFTER_DRAIN = false;
    bf16_t* O; int ldc;
    __device__ __forceinline__ void operator()(const f32x4 (&acc)[2][2][4][2], const Unit& u, int wr, int wc, int fr, int fq) const {
        const int row0 = u.pm * BM + wr * 64 + fr, col0 = u.pn * BM + wc * 32 + 8 * fq;
#pragma unroll
        for (int ai = 0; ai < 2; ++ai)
#pragma unroll
            for (int m = 0; m < 4; ++m) { bf16_t* rowp = O + (size_t)(row0 + ai * HALF + m * 16) * ldc + col0;
#pragma unroll
                for (int bj = 0; bj < 2; ++bj) { f32x4 v0 = acc[ai][bj][m][0], v1 = acc[ai][bj][m][1];
#pragma unroll
                    for (int e = 0; e < 4; ++e) { v0[e] = v0[e] > 0.f ? v0[e] : 0.f; v1[e] = v1[e] > 0.f ? v1[e] : 0.f; }
                    v0 = v0 * v0; v1 = v1 * v1;
                    u32x4 w; w.x = cvt_pk_bf16(v0[0], v0[1]); w.y = cvt_pk_bf16(v0[2], v0[3]); w.z = cvt_pk_bf16(v1[0], v1[1]); w.w = cvt_pk_bf16(v1[2], v1[3]);
                    *(u32x4*)(rowp + bj * HALF) = w; } }
    }
};
struct EpiInProj {
    static constexpr bool PERM = true, AFTER_DRAIN = false;
    bf16_t* Q; bf16_t* KV; bf16_t* C3; float* gates; float qscale;
    __device__ __forceinline__ void operator()(const f32x4 (&acc)[2][2][4][2], const Unit& u, int wr, int wc, int fr, int fq) const {
        const int pn = u.pn;
        const int row0 = u.pm * BM + wr * 64 + fr, cc0 = wc * 32 + 8 * fq;
#pragma unroll
        for (int ai = 0; ai < 2; ++ai)
#pragma unroll
            for (int m = 0; m < 4; ++m) { const int r = row0 + ai * HALF + m * 16;
#pragma unroll
                for (int bj = 0; bj < 2; ++bj) { f32x4 v0 = acc[ai][bj][m][0], v1 = acc[ai][bj][m][1];
                    const int cc = cc0 + bj * HALF;
                    if (pn == 22) {
                        if (bj == 0 && cc < 24) {
#pragma unroll
                            for (int e = 0; e < 4; ++e) { gates[(size_t)r * 24 + cc + e] = 1.f / (1.f + __expf(-v0[e])); gates[(size_t)r * 24 + cc + 4 + e] = 1.f / (1.f + __expf(-v1[e])); }
                        }
                    } else {
                        bf16_t* dst;
                        if (pn < 4) { v0 = v0 * qscale; v1 = v1 * qscale; dst = Q + (size_t)r * 1024 + pn * 256 + cc; }
                        else if (pn < 10) { const int b = r >> 12, t = r & 4095; dst = KV + (size_t)(pn - 4) * (4 * 4096 * 128) + ((size_t)((b * 2 + bj) * 4096 + t)) * 128 + cc0; }
                        else { const int idx = (pn - 10) >> 2; dst = C3 + (size_t)idx * (8192 * 1024) + (size_t)r * 1024 + ((pn - 10) & 3) * 256 + cc; }
                        u32x4 w; w.x = cvt_pk_bf16(v0[0], v0[1]); w.y = cvt_pk_bf16(v0[2], v0[3]); w.z = cvt_pk_bf16(v1[0], v1[1]); w.w = cvt_pk_bf16(v1[2], v1[3]);
                        *(u32x4*)dst = w;
                    } } }
    }
};
struct OneUnit {
    bool has; Unit u;
    __device__ __forceinline__ bool next(int i, Unit& o) const { if (i == 0 && has) { o = u; return true; } return false; }
    __device__ __forceinline__ void a_ready(const Unit&) const {}
    __device__ __forceinline__ void done(const Unit&) const {}
};

template <class Epi, class Sched, bool ALIGN_EPI = false, bool SP2 = false>
__device__ __forceinline__ void gemm_phase(PG8_LAS unsigned char* lds, const Gemm g, const Sched& S, const Epi& E) {
    const int tid = threadIdx.x, wid = __builtin_amdgcn_readfirstlane(tid >> 6), lane = tid & 63, wr = wid >> 2, wc = wid & 3, fr = lane & 15, fq = lane >> 4;
    const int K = g.K, nt = K / BK;
    unsigned voffA[2], voffB[2];
#pragma unroll
    for (int i = 0; i < 2; ++i) { int R, C; stage_rc(tid * 16 + i * 8192, R, C); const int Rb = Epi::PERM ? ((R & ~31) + perm32(R & 31)) : R;
        voffA[i] = (unsigned)(R * g.lda + C) * 2u; voffB[i] = (unsigned)(Rb * g.ldb + C) * 2u; }
    const size_t kstep = (size_t)(BK * 2);
    const size_t hstepA = (size_t)HALF * g.lda * 2, hstepB = (size_t)HALF * g.ldb * 2;
    const size_t tstepA = 2 * hstepA, tstepB = 2 * hstepB;
    const unsigned ldsw = (unsigned)wid * 1024u;
    const int aoff = lds_byte(wr * 64 + fr, fq * 8), boff = lds_byte(wc * 32 + fr, fq * 8);
#define PG8_SA(b, h) (((b) * 2 + (h)) * HTB)
#define PG8_SB(b, h) ((4 + (b) * 2 + (h)) * HTB)
#define PG8_STAGE(bufoff, gbase, voff) do { _Pragma("unroll") for (int _i = 0; _i < 2; ++_i) \
        __builtin_amdgcn_global_load_lds((const unsigned*)((const char*)(gbase) + (voff)[_i]), (PG8_LAS unsigned*)(lds + (bufoff) + ldsw + _i * 8192), 16, 0, 0); } while (0)
#define PG8_LDA(dst, b, h) do { _Pragma("unroll") for (int m = 0; m < 4; ++m) _Pragma("unroll") for (int k = 0; k < 2; ++k) dst[m][k] = *(const PG8_LAS bf16x8*)(lds + PG8_SA(b, h) + aoff + m * 2048 + k * 1024); } while (0)
#define PG8_LDB(dst, b, h) do { _Pragma("unroll") for (int n = 0; n < 2; ++n) _Pragma("unroll") for (int k = 0; k < 2; ++k) dst[n][k] = *(const PG8_LAS bf16x8*)(lds + PG8_SB(b, h) + boff + n * 2048 + k * 1024); } while (0)
#define PG8_MMA(ai, bj, At, Bt) do { __builtin_amdgcn_s_setprio(1); _Pragma("unroll") for (int m = 0; m < 4; ++m) _Pragma("unroll") for (int n = 0; n < 2; ++n) _Pragma("unroll") for (int k = 0; k < 2; ++k) \
        acc[ai][bj][m][n] = __builtin_amdgcn_mfma_f32_16x16x32_bf16(Bt[n][k], At[m][k], acc[ai][bj][m][n], 0, 0, 0); __builtin_amdgcn_s_setprio(0); } while (0)
#define PG8_WAIT_V(n) asm volatile("s_waitcnt vmcnt(" #n ")" ::: "memory")
#define PG8_WAIT_L(n) asm volatile("s_waitcnt lgkmcnt(" #n ")" ::: "memory")
#define PG8_BAR __builtin_amdgcn_s_barrier()
#define PG8_SCHED __builtin_amdgcn_sched_barrier(0)
    Unit cur, nxt; int ui = 0;
    if (!S.next(0, cur)) return;
    f32x4 acc[2][2][4][2];
#pragma unroll
    for (int a = 0; a < 2; ++a)
#pragma unroll
        for (int b = 0; b < 2; ++b)
#pragma unroll
            for (int m = 0; m < 4; ++m)
#pragma unroll
                for (int n = 0; n < 2; ++n) acc[a][b][m][n] = (f32x4){0.f, 0.f, 0.f, 0.f};
    bf16x8 At[4][2], B0[2][2], B1[2][2];
    const char* cA = (const char*)g.A + (size_t)cur.pm * tstepA; const char* cB = (const char*)g.Bt + (size_t)cur.pn * tstepB;
    S.a_ready(cur);
    if constexpr (SP2) {
        PG8_STAGE(PG8_SB(0, 0), cB, voffB); PG8_STAGE(PG8_SB(0, 1), cB + hstepB, voffB); PG8_STAGE(PG8_SA(0, 0), cA, voffA); PG8_STAGE(PG8_SA(0, 1), cA + hstepA, voffA);
        if (wr == 1) PG8_BAR;
        PG8_WAIT_V(2); PG8_BAR;
        PG8_STAGE(PG8_SB(1, 0), cB + kstep, voffB); PG8_STAGE(PG8_SA(1, 0), cA + kstep, voffA); PG8_STAGE(PG8_SB(1, 1), cB + hstepB + kstep, voffB);
        PG8_WAIT_V(6); PG8_BAR;
    } else {
        PG8_STAGE(PG8_SB(0, 0), cB, voffB); PG8_STAGE(PG8_SA(0, 0), cA, voffA); PG8_STAGE(PG8_SB(0, 1), cB + hstepB, voffB); PG8_STAGE(PG8_SA(0, 1), cA + hstepA, voffA);
        if (wr == 1) PG8_BAR;
        PG8_WAIT_V(4); PG8_BAR;
        PG8_STAGE(PG8_SB(1, 0), cB + kstep, voffB); PG8_STAGE(PG8_SA(1, 0), cA + kstep, voffA); PG8_STAGE(PG8_SB(1, 1), cB + hstepB + kstep, voffB);
        PG8_WAIT_V(6); PG8_BAR;
    }
    for (;;) {
        const bool has_next = S.next(ui + 1, nxt);
        const char* nA = has_next ? (const char*)g.A + (size_t)nxt.pm * tstepA : cA; const char* nB = has_next ? (const char*)g.Bt + (size_t)nxt.pn * tstepB : cB;
        for (int t = 0; t < nt; t += 2) {
            const bool last = (t == nt - 2);
            const char* a1 = cA + (size_t)(t + 1) * kstep;
            const char* a2 = last ? nA : cA + (size_t)(t + 2) * kstep; const char* b2 = last ? nB : cB + (size_t)(t + 2) * kstep;
            const char* a3 = a2 + kstep; const char* b3 = b2 + kstep;
            if (last && has_next) S.a_ready(nxt);
            if constexpr (SP2) {
            PG8_LDB(B0, 0, 0); PG8_LDB(B1, 0, 1); PG8_SCHED; PG8_LDA(At, 0, 0); PG8_STAGE(PG8_SA(1, 1), a1 + hstepA, voffA);
            PG8_WAIT_V(8); PG8_WAIT_L(0); PG8_BAR; PG8_MMA(0, 0, At, B0); PG8_MMA(0, 1, At, B1); PG8_BAR; PG8_SCHED;
            PG8_LDA(At, 0, 1); PG8_STAGE(PG8_SB(0, 0), b2, voffB); PG8_STAGE(PG8_SB(0, 1), b2 + hstepB, voffB); PG8_STAGE(PG8_SA(0, 0), a2, voffA);
            PG8_WAIT_V(8); PG8_WAIT_L(0); PG8_BAR; PG8_MMA(1, 0, At, B0); PG8_MMA(1, 1, At, B1); PG8_BAR; PG8_SCHED;
            PG8_LDB(B0, 1, 0); PG8_LDB(B1, 1, 1); PG8_SCHED; PG8_LDA(At, 1, 0); PG8_STAGE(PG8_SA(0, 1), a2 + hstepA, voffA);
            PG8_WAIT_V(8); PG8_WAIT_L(0); PG8_BAR; PG8_MMA(0, 0, At, B0); PG8_MMA(0, 1, At, B1); PG8_BAR; PG8_SCHED;
            PG8_LDA(At, 1, 1); PG8_STAGE(PG8_SB(1, 0), b3, voffB); PG8_STAGE(PG8_SB(1, 1), b3 + hstepB, voffB); PG8_STAGE(PG8_SA(1, 0), a3, voffA);
            PG8_WAIT_V(8); PG8_WAIT_L(0); PG8_BAR; PG8_MMA(1, 0, At, B0); PG8_MMA(1, 1, At, B1); PG8_BAR; PG8_SCHED;
            } else {
            PG8_LDB(B0, 0, 0); PG8_SCHED; PG8_LDA(At, 0, 0); PG8_STAGE(PG8_SA(1, 1), a1 + hstepA, voffA);
            PG8_WAIT_L(8); PG8_BAR; PG8_WAIT_L(0); PG8_MMA(0, 0, At, B0); PG8_BAR; PG8_SCHED;
            PG8_LDB(B1, 0, 1); PG8_STAGE(PG8_SB(0, 0), b2, voffB);
            PG8_BAR; PG8_WAIT_L(0); PG8_MMA(0, 1, At, B1); PG8_BAR;
            PG8_LDA(At, 0, 1); PG8_STAGE(PG8_SA(0, 0), a2, voffA);
            PG8_BAR; PG8_WAIT_L(0); PG8_MMA(1, 0, At, B0); PG8_BAR; PG8_SCHED;
            PG8_STAGE(PG8_SB(0, 1), b2 + hstepB, voffB);
            PG8_WAIT_V(6); PG8_BAR; PG8_MMA(1, 1, At, B1); PG8_BAR;
            PG8_LDB(B0, 1, 0); PG8_SCHED; PG8_LDA(At, 1, 0); PG8_STAGE(PG8_SA(0, 1), a2 + hstepA, voffA);
            PG8_WAIT_L(8); PG8_BAR; PG8_WAIT_L(0); PG8_MMA(0, 0, At, B0); PG8_BAR; PG8_SCHED;
            PG8_LDB(B1, 1, 1); PG8_STAGE(PG8_SB(1, 0), b3, voffB);
            PG8_BAR; PG8_WAIT_L(0); PG8_MMA(0, 1, At, B1); PG8_BAR;
            PG8_LDA(At, 1, 1); PG8_STAGE(PG8_SA(1, 0), a3, voffA);
            PG8_BAR; PG8_WAIT_L(0); PG8_MMA(1, 0, At, B0); PG8_BAR; PG8_SCHED;
            PG8_STAGE(PG8_SB(1, 1), b3 + hstepB, voffB);
            PG8_WAIT_V(6); PG8_BAR; PG8_MMA(1, 1, At, B1); PG8_BAR;
            }
        }
        if constexpr (ALIGN_EPI) { if (wr == 0) PG8_BAR; }
        if constexpr (!Epi::AFTER_DRAIN) { E(acc, cur, wr, wc, fr, fq); S.done(cur); }
        if (!has_next) break;
#pragma unroll
        for (int a = 0; a < 2; ++a)
#pragma unroll
            for (int b = 0; b < 2; ++b)
#pragma unroll
                for (int m = 0; m < 4; ++m)
#pragma unroll
                    for (int n = 0; n < 2; ++n) acc[a][b][m][n] = (f32x4){0.f, 0.f, 0.f, 0.f};
        cur = nxt; cA = nA; cB = nB; ++ui;
        if constexpr (ALIGN_EPI) { if (wr == 1) PG8_BAR; }
    }
    PG8_WAIT_V(0);
    if constexpr (!ALIGN_EPI) { if (wr == 0) PG8_BAR; }
    PG8_BAR;
    if constexpr (Epi::AFTER_DRAIN) { E.fused(acc, cur, wr, wc, fr, fq, lds, wid, lane); S.done(cur); }
#undef PG8_SA
#undef PG8_SB
#undef PG8_STAGE
#undef PG8_LDA
#undef PG8_LDB
#undef PG8_MMA
#undef PG8_WAIT_V
#undef PG8_WAIT_L
#undef PG8_BAR
#undef PG8_SCHED
}
}
#define GAS __attribute__((address_space(1)))
#define LAS __attribute__((address_space(3)))
typedef unsigned short bf16;
typedef unsigned v4u __attribute__((ext_vector_type(4)));
typedef float f32x4 __attribute__((ext_vector_type(4)));
typedef short bf16x8 __attribute__((ext_vector_type(8)));
typedef GAS unsigned gu32;
typedef GAS unsigned long long gu64;
#define RLX_AGENT __ATOMIC_RELAXED, __HIP_MEMORY_SCOPE_AGENT
#define LDS_WAIT() asm volatile("s_waitcnt lgkmcnt(0)" ::: "memory")
#define VM_WAIT() asm volatile("s_waitcnt vmcnt(0)" ::: "memory")
__device__ __forceinline__ unsigned long long rt() { return __builtin_amdgcn_s_memrealtime(); }
__device__ __forceinline__ unsigned f2bf(float f) { unsigned u = __builtin_bit_cast(unsigned, f); return (u + 0x7fffu + ((u >> 16) & 1u)) >> 16; }
__device__ __forceinline__ unsigned pk2(float lo, float hi) { return f2bf(lo) | (f2bf(hi) << 16); }

#define XB_TMO      128
#define XB_XCNT(j)  (256  + 64 * (j))
#define XB_XSUB(j)  (1280 + 64 * (j))
#define XB_XGEN(j)  (2304 + 64 * (j))
#define XB_TOP      3328
#define XB_TOPGEN   3392
#define XCD_BAR_WORDS 3456
#define XB_SPIN_CAP (1u << 18)

__device__ __forceinline__ unsigned xb_ld(unsigned* p)              { return __hip_atomic_load(p, __ATOMIC_RELAXED, __HIP_MEMORY_SCOPE_AGENT); }
__device__ __forceinline__ unsigned xb_add(unsigned* p, unsigned v) { return __hip_atomic_fetch_add(p, v, __ATOMIC_RELAXED, __HIP_MEMORY_SCOPE_AGENT); }
__device__ __forceinline__ unsigned xb_xcc_id() { return (unsigned)__builtin_amdgcn_s_getreg((3 << 11) | 20) & 0xFu; }
#define XB_SPIN(cond, bar) do { unsigned _sp = 0; while (cond) { __builtin_amdgcn_s_sleep(1); \
    if ((++_sp & 255u) == 0u) { if (xb_ld(&(bar)[XB_TMO])) break; if (_sp > XB_SPIN_CAP) { atomicAdd(&(bar)[XB_TMO], 1u); break; } } } } while (0)

struct XcdBarrier {
    unsigned* bar; unsigned x;
    volatile LAS unsigned* st;
};

__device__ __forceinline__ XcdBarrier xcd_barrier_post(unsigned* bar, volatile LAS unsigned* st) {
    XcdBarrier b; b.bar = bar; b.x = xb_xcc_id(); b.st = st;
    if (threadIdx.x == 0) (void)xb_add(&bar[XB_XCNT(b.x)], 1u);
    return b;
}
__device__ __forceinline__ void xcd_barrier_complete(unsigned* bar, unsigned x, unsigned& nloc, unsigned& nx) {
    const unsigned G = gridDim.x * gridDim.y * gridDim.z;
    unsigned sum, cnt, mine, sp = 0u;
    for (;;) {
        sum = 0u; cnt = 0u; mine = 0u;
#pragma unroll
        for (unsigned j = 0; j < 16; ++j) { const unsigned c = xb_ld(&bar[XB_XCNT(j)]); sum += c; cnt += (c > 0u) ? 1u : 0u; mine = (j == x) ? c : mine; }
        if (sum == G) break;
        __builtin_amdgcn_s_sleep(1);
        if ((++sp & 255u) == 0u) { if (xb_ld(&bar[XB_TMO])) break; if (sp > XB_SPIN_CAP) { atomicAdd(&bar[XB_TMO], 1u); break; } }
    }
    nloc = mine > 0u ? mine : 1u; nx = cnt > 0u ? cnt : 1u;
}

__device__ __forceinline__ void xcd_barrier(const XcdBarrier& b) {
    asm volatile("s_waitcnt vmcnt(0)" ::: "memory");
    __syncthreads();
    if (threadIdx.x == 0) {
        unsigned* bar = b.bar;
        __builtin_amdgcn_s_waitcnt(0);
        unsigned nloc = b.st[0], nx = b.st[1];
        if (nloc == 0u) { xcd_barrier_complete(bar, b.x, nloc, nx); b.st[0] = nloc; b.st[1] = nx; }
        const unsigned old = xb_add(&bar[XB_XSUB(b.x)], 1u);
        const unsigned gen = old / nloc;
        if (old + 1u == (gen + 1u) * nloc) {
            __builtin_amdgcn_fence(__ATOMIC_RELEASE, "agent");
            asm volatile("s_waitcnt vmcnt(0)" ::: "memory");
            const unsigned og = xb_add(&bar[XB_TOP], 1u);
            const unsigned tg = og / nx;
            if (og + 1u == (tg + 1u) * nx) xb_add(&bar[XB_TOPGEN], 1u);
            else XB_SPIN(xb_ld(&bar[XB_TOPGEN]) == tg, bar);
            __builtin_amdgcn_fence(__ATOMIC_ACQUIRE, "agent");
            xb_add(&bar[XB_XGEN(b.x)], 1u);
            asm volatile("s_waitcnt vmcnt(0)" ::: "memory");
        } else {
            XB_SPIN(xb_ld(&bar[XB_XGEN(b.x)]) == gen, bar);
            __builtin_amdgcn_fence(__ATOMIC_ACQUIRE, "agent");
            asm volatile("s_waitcnt vmcnt(0)" ::: "memory");
        }
    }
    __syncthreads();
}
constexpr int NWAVES = 8;
constexpr int B_ = 2, T_ = 4096, D_ = 2048, M_ = B_ * T_;
constexpr int NKV = 2, HD = 128, NCMP = 255, NSEL = 64, TOPK = 16, WIN = 512;
constexpr int DFF = 8192, INW = 5656, NQT = 5888;
constexpr float EPS = 1e-6f, NEGV = -1e30f, FORCEV = 1e9f;
constexpr float LOG2E = 1.4426950408889634f;
constexpr float QSCALE = 0.08838834764831845f * 1.4426950408889634f;

constexpr size_t MiB = 1u << 20;
constexpr size_t WS_CTL = 0, CTL_ZERO_BYTES = 131072;
constexpr size_t WS_PEB = 1 * MiB;
constexpr size_t WS_SELM = 1 * MiB + 128 * 1024;
constexpr size_t WS_KCMP = 1 * MiB + 256 * 1024;
constexpr size_t WS_VCMP = 1 * MiB + 512 * 1024;
constexpr size_t WS_GATES = 2 * MiB;
constexpr size_t WS_WDN = 4 * MiB, WS_WUP = 36 * MiB;
constexpr size_t WS_H = 68 * MiB;
constexpr size_t WS_F = 36 * MiB;
constexpr size_t WS_U = 100 * MiB;
constexpr size_t WS_WIN = 100 * MiB;
constexpr size_t WS_SLAB = 100 * MiB;
constexpr size_t WS_WO = 124 * MiB;
constexpr size_t WS_W1 = 132 * MiB;
constexpr size_t WS_Q = 136 * MiB;
constexpr size_t WS_KV = 152 * MiB;
constexpr size_t WS_C3 = 176 * MiB;
constexpr size_t WS_OC = 228 * MiB, WS_OW = 244 * MiB;
constexpr size_t WS_END = 260 * MiB;
constexpr size_t KVSZ = (size_t)4 * 4096 * 128;

constexpr int RING_BYTES = 135168;
constexpr int LDSCTL_OFF = RING_BYTES, MISC_OFF = LDSCTL_OFF + 320;
constexpr int LDS_BYTES = RING_BYTES + 1024;

__device__ __constant__ unsigned char BUCKET_TAB[128] = {
  0, 1, 2, 3, 4, 5, 6, 7, 8, 9, 10, 11, 12, 13, 14, 15, 16, 16, 16, 17, 17, 18, 18, 18, 19, 19, 19, 20, 20, 20, 20, 21, 21, 21, 21, 22, 22, 22, 22, 22,
  23, 23, 23, 23, 23, 23, 24, 24, 24, 24, 24, 24, 25, 25, 25, 25, 25, 25, 25, 26, 26, 26, 26, 26, 26, 26, 26, 27, 27, 27, 27, 27, 27, 27, 27, 27, 27,
  28, 28, 28, 28, 28, 28, 28, 28, 28, 28, 29, 29, 29, 29, 29, 29, 29, 29, 29, 29, 29, 29, 30, 30, 30, 30, 30, 30, 30, 30, 30, 30, 30, 30, 30, 30,
  31, 31, 31, 31, 31, 31, 31, 31, 31, 31, 31, 31, 31, 31, 31};
__device__ __forceinline__ int rel_bucket(int dist) { int n = dist < 0 ? 0 : dist; return n >= 113 ? 31 : (int)BUCKET_TAB[n]; }
__device__ __forceinline__ int rel_bucket_arith(int n) {
    int r = 16 + (n >= 19) + (n >= 21) + (n >= 24) + (n >= 27) + (n >= 31) + (n >= 35) + (n >= 40) + (n >= 46) + (n >= 52) + (n >= 59) + (n >= 67) + (n >= 77) + (n >= 87) + (n >= 99) + (n >= 113);
    return n < 16 ? n : r;
}
__device__ __forceinline__ float bf2f(unsigned short v) { return __builtin_bit_cast(float, (unsigned)v << 16); }

__device__ __forceinline__ float wave_sum(float v) {
#pragma unroll
    for (int o = 1; o < 64; o <<= 1) v += __shfl_xor(v, o);
    return v;
}

__device__ __forceinline__ int win_src_col(int n) { return n < 2560 ? n : (n < 5632 ? n + 24 : (n < 5656 ? n - 5632 + 2560 : -1)); }
__device__ __forceinline__ void p0_transpose_item(const float* W, int ldw, int K, int nblk, bf16* WT, LAS float* scr, int item, int lane, bool remap) {
    const int kb = item / nblk, nb = item % nblk, k0 = 64 * kb, n0 = 64 * nb;
    const int c4 = (lane & 15) * 4, kr = lane >> 4;
    const int nn = n0 + c4; const int sc = remap ? win_src_col(nn) : nn;
    f32x4 v[16];
#pragma unroll
    for (int i = 0; i < 16; ++i) v[i] = sc >= 0 ? *(const GAS f32x4*)(W + (size_t)(k0 + kr + 4 * i) * ldw + sc) : (f32x4){0.f, 0.f, 0.f, 0.f};
#pragma unroll
    for (int i = 0; i < 16; ++i) { LAS float* d = scr + (kr + 4 * i) * 65 + c4; d[0] = v[i].x; d[1] = v[i].y; d[2] = v[i].z; d[3] = v[i].w; }
    LDS_WAIT(); asm volatile("" ::: "memory");
    const int c = lane & 7;
#pragma unroll
    for (int j = 0; j < 8; ++j) { const int n = (lane >> 3) + 8 * j; const LAS float* sp = scr + (8 * c) * 65 + n;
        v4u o; o.x = pk2(sp[0 * 65], sp[1 * 65]); o.y = pk2(sp[2 * 65], sp[3 * 65]); o.z = pk2(sp[4 * 65], sp[5 * 65]); o.w = pk2(sp[6 * 65], sp[7 * 65]);
        *(GAS v4u*)(WT + (size_t)(n0 + n) * K + k0 + 8 * c) = o; }
    LDS_WAIT(); asm volatile("" ::: "memory");
}
__device__ __forceinline__ void rms_row_to_bf16(const float* xrow, const float* gain, bf16* orow, int lane) {
    const GAS f32x4* xr = (const GAS f32x4*)xrow + lane; const GAS f32x4* gr = (const GAS f32x4*)gain + lane;
    f32x4 v[8]; float s = 0.f;
#pragma unroll
    for (int j = 0; j < 8; ++j) { v[j] = xr[64 * j]; s += (v[j].x * v[j].x + v[j].y * v[j].y) + (v[j].z * v[j].z + v[j].w * v[j].w); }
    const float r = rsqrtf(wave_sum(s) * (1.f / D_) + EPS);
    GAS unsigned long long* o8 = (GAS unsigned long long*)orow + lane;
#pragma unroll
    for (int j = 0; j < 8; ++j) { const f32x4 g = gr[64 * j];
        o8[64 * j] = (unsigned long long)pk2((v[j].x * r) * g.x, (v[j].y * r) * g.y) | ((unsigned long long)pk2((v[j].z * r) * g.z, (v[j].w * r) * g.w) << 32); }
}

namespace att {
typedef short bf16x8 __attribute__((ext_vector_type(8)));
typedef short s16x4 __attribute__((ext_vector_type(4)));
typedef float f32x16 __attribute__((ext_vector_type(16)));
typedef float f32x2_t __attribute__((ext_vector_type(2)));
typedef __bf16 bf16x2_t __attribute__((ext_vector_type(2)));
typedef short v4i16_t __attribute__((ext_vector_type(4)));
typedef LAS const char* lcp;
__device__ __forceinline__ unsigned cvtpk(float lo, float hi) { f32x2_t v = {lo, hi}; bf16x2_t b = __builtin_convertvector(v, bf16x2_t); return __builtin_bit_cast(unsigned, b); }
__device__ __forceinline__ s16x4 vtr(lcp p) { return __builtin_bit_cast(s16x4, __builtin_amdgcn_ds_read_tr16_b64_v4i16((LAS v4i16_t*)p)); }

constexpr int KB0 = 0, VB0 = 32768, BIAS_OFF = 65536, IMP_OFF = 65536 + 2048, IMP_FLOATS = 2 * 4 * 64 * 33;
constexpr float MINIT = -1e29f, MASKED = -1e30f;

struct TileRegs { v4u k[2], v[2]; };
__device__ __forceinline__ void tile_load(TileRegs& R, const bf16* Kg, const bf16* Vg, int tid) {
#pragma unroll
    for (int i = 0; i < 2; ++i) { const int ci = tid + 512 * i;
        R.k[i] = *(const GAS v4u*)((const char*)Kg + ci * 16); R.v[i] = *(const GAS v4u*)((const char*)Vg + ci * 16); }
}
__device__ __forceinline__ void tile_store(LAS unsigned char* lds, int buf, const TileRegs& R, int tid) {
#pragma unroll
    for (int i = 0; i < 2; ++i) { const int ci = tid + 512 * i, row = ci >> 4, ch = ci & 15;
        *(LAS v4u*)(lds + KB0 + buf * 16384 + row * 256 + ((ch ^ (row & 15)) << 4)) = R.k[i];
        *(LAS v4u*)(lds + VB0 + buf * 16384 + row * 256 + ((ch ^ (((row & 3) << 2) | ((row >> 2) & 3))) << 4)) = R.v[i]; }
}
__device__ __forceinline__ void qk_tile(f32x16& p0, f32x16& p1, lcp kb, const bf16x8 (&qf)[8], int lane, float init) {
    const int r = lane & 31, h2 = lane >> 5;
#pragma unroll
    for (int e = 0; e < 16; ++e) { p0[e] = init; p1[e] = init; }
    lcp k0 = kb + r * 256, k1 = kb + (r + 32) * 256;
#pragma unroll
    for (int s = 0; s < 8; ++s) { const int off = ((2 * s + h2) ^ (r & 15)) << 4;
        const bf16x8 a0 = *(const LAS bf16x8*)(k0 + off), a1 = *(const LAS bf16x8*)(k1 + off);
        p0 = __builtin_amdgcn_mfma_f32_32x32x16_bf16(a0, qf[s], p0, 0, 0, 0);
        p1 = __builtin_amdgcn_mfma_f32_32x32x16_bf16(a1, qf[s], p1, 0, 0, 0); }
}
__device__ __forceinline__ void pv_tile(f32x16 (&o)[4], lcp vb, const bf16x8 (&pf)[4], int lane) {
    const int i16 = lane & 15, q4 = i16 >> 2, p4 = i16 & 3, gl = (lane >> 4) & 1, h2 = lane >> 5;
#pragma unroll
    for (int s = 0; s < 4; ++s) { const int base = 32 * (s >> 1) + 16 * (s & 1);
        const int key1 = base + 4 * h2 + q4, key2 = key1 + 8;
        const int sw1 = ((key1 & 3) << 2) | ((key1 >> 2) & 3), sw2 = ((key2 & 3) << 2) | ((key2 >> 2) & 3);
        lcp r1 = vb + key1 * 256 + 8 * (p4 & 1), r2 = vb + key2 * 256 + 8 * (p4 & 1);
#pragma unroll
        for (int db = 0; db < 4; ++db) { const int ch = 4 * db + 2 * gl + (p4 >> 1);
            const s16x4 lo = vtr(r1 + ((ch ^ sw1) << 4)), hi = vtr(r2 + ((ch ^ sw2) << 4));
            bf16x8 a; a[0] = lo[0]; a[1] = lo[1]; a[2] = lo[2]; a[3] = lo[3]; a[4] = hi[0]; a[5] = hi[1]; a[6] = hi[2]; a[7] = hi[3];
            o[db] = __builtin_amdgcn_mfma_f32_32x32x16_bf16(a, pf[s], o[db], 0, 0, 0); } }
}
#define ATT_OFF(r) (((r) & 3) + 8 * ((r) >> 2))
#define LADD(p, v) (void)__hip_atomic_fetch_add((p), (v), __ATOMIC_RELAXED, __HIP_MEMORY_SCOPE_WORKGROUP)

struct AttnBufs { const bf16* Q; const bf16* K; const bf16* V; int kvrows;
                  const float* rel_bias; const unsigned long long* selm_in; unsigned long long* selm_out; const float* gates;
                  bf16* OC; bf16* OW; bf16* AO; };

template <int MODE>
__device__ __forceinline__ void attn_item(LAS unsigned char* lds, const AttnBufs& P, int b, int g, int qA0, int qB0, int tid, int lane, int wave) {
    const int half = wave >> 2, hh = wave & 3, head = g * 4 + hh, bg = b * NKV + g;
    const int q0 = half ? qB0 : qA0, ql = lane & 31, hi = lane >> 5, t = q0 + ql;
    const size_t row = (size_t)b * T_ + t;
    int jlo_w, jhi_w, jlo_g, jhi_g;
    if (MODE == 0) { jlo_w = 0; jhi_w = (q0 + 31) >> 6; jlo_g = 0; const int qm = qA0 > qB0 ? qA0 : qB0; jhi_g = (qm + 31) >> 6; }
    else if (MODE == 1) { const int lo_ = q0 - (WIN - 1); jlo_w = lo_ < 0 ? 0 : (lo_ >> 6); jhi_w = (q0 + 31) >> 6;
                          const int qn = qA0 < qB0 ? qA0 : qB0, qm = qA0 > qB0 ? qA0 : qB0; const int lg = qn - (WIN - 1); jlo_g = lg < 0 ? 0 : (lg >> 6); jhi_g = (qm + 31) >> 6; }
    else { jlo_w = 0; jhi_w = q0 >> 10; jlo_g = 0; const int qm = qA0 > qB0 ? qA0 : qB0; jhi_g = qm >> 10; }
    const bf16* Kg = P.K + (size_t)bg * P.kvrows * HD; const bf16* Vg = P.V + (size_t)bg * P.kvrows * HD;
    { const int h_ = tid >> 7, idx = tid & 127; ((LAS float*)(lds + BIAS_OFF))[tid] = idx <= 113 ? P.rel_bias[(g * 4 + h_) * 32 + rel_bucket_arith(idx)] * LOG2E : 0.f; }
    if (MODE == 2) { for (int i = tid; i < IMP_FLOATS; i += 512) ((LAS float*)(lds + IMP_OFF))[i] = 0.f; }
    bf16x8 qf[8];
    { const bf16* qp = P.Q + row * 1024 + head * HD + 8 * hi;
#pragma unroll
      for (int s = 0; s < 8; ++s) qf[s] = *(const GAS bf16x8*)(qp + 16 * s); }
    unsigned long long selm = 0ull;
    if (MODE == 0) selm = P.selm_in[(size_t)bg * T_ + t];
    const LAS float* bt = (const LAS float*)(lds + BIAS_OFF) + hh * 128;
    const float b31 = P.rel_bias[(g * 4 + hh) * 32 + 31] * LOG2E;
    f32x16 o[4];
#pragma unroll
    for (int d = 0; d < 4; ++d)
#pragma unroll
        for (int e = 0; e < 16; ++e) o[d][e] = 0.f;
    float m = MINIT, l = 0.f, invl = 0.f;
    const int cmax = (MODE == 2) ? (((t - 31) >> 4) < 254 ? ((t - 31) >> 4) : 254) : 0;

    constexpr int NPASS = (MODE == 2) ? 2 : 1;
#pragma unroll 1
    for (int pass = 0; pass < NPASS; ++pass) {
        TileRegs R;
        tile_load(R, Kg + (size_t)jlo_g * 64 * HD, Vg + (size_t)jlo_g * 64 * HD, tid);
        tile_store(lds, 0, R, tid);
        __syncthreads();
#pragma unroll 1
        for (int j = jlo_g; j <= jhi_g; ++j) {
            const int cur = (j - jlo_g) & 1;
            const bool more = j < jhi_g;
            if (more) tile_load(R, Kg + (size_t)(j + 1) * 64 * HD, Vg + (size_t)(j + 1) * 64 * HD, tid);
            if (j >= jlo_w && j <= jhi_w) {
                f32x16 p0, p1;
                const bool far = (MODE == 0) ? (64 * j + 63 + 113 <= q0) : (MODE == 1) ? (64 * j + 63 + 113 <= q0 && (q0 + 31) - 64 * j < WIN) : false;
                qk_tile(p0, p1, (lcp)(lds + KB0 + cur * 16384), qf, lane, far ? b31 : 0.f);
                float mx = MASKED;
                bool lane_on = true;
                if (MODE != 2 && far) {
                    float a_ = fmaxf(p0[0], p1[0]), b_ = fmaxf(p0[1], p1[1]);
#pragma unroll
                    for (int r = 2; r < 16; r += 2) { a_ = fmaxf(a_, fmaxf(p0[r], p1[r])); b_ = fmaxf(b_, fmaxf(p0[r + 1], p1[r + 1])); }
                    mx = fmaxf(a_, b_);
                    if (MODE == 0) { lane_on = ((selm >> j) & 1ull) != 0ull; mx = lane_on ? mx : MASKED; }
                } else if (MODE == 2) {
                    const int c0 = 64 * j + 4 * hi, dd0 = t - 31 - 16 * c0;
#pragma unroll
                    for (int r = 0; r < 16; ++r) {
                        { const int c = c0 + ATT_OFF(r), dist = dd0 - 16 * ATT_OFF(r); const int idx = dist < 0 ? 0 : (dist > 113 ? 113 : dist);
                          float s = p0[r] + bt[idx]; s = (c <= cmax) ? s : MASKED; p0[r] = s; mx = fmaxf(mx, s); }
                        { const int c = c0 + 32 + ATT_OFF(r), dist = dd0 - 512 - 16 * ATT_OFF(r); const int idx = dist < 0 ? 0 : (dist > 113 ? 113 : dist);
                          float s = p1[r] + bt[idx]; s = (c <= cmax) ? s : MASKED; p1[r] = s; mx = fmaxf(mx, s); }
                    }
                } else {
                    const int d0 = t - (64 * j + 4 * hi);
                    const bool selb = (MODE == 0) ? (((selm >> j) & 1ull) != 0ull) : true;
#pragma unroll
                    for (int r = 0; r < 16; ++r) {
                        { const int dist = d0 - ATT_OFF(r); const int idx = dist < 0 ? 0 : (dist > 113 ? 113 : dist);
                          const bool valid = (MODE == 0) ? (dist >= 0 && selb) : (dist >= 0 && dist < WIN);
                          float s = p0[r] + bt[idx]; s = valid ? s : MASKED; p0[r] = s; mx = fmaxf(mx, s); }
                        { const int dist = d0 - 32 - ATT_OFF(r); const int idx = dist < 0 ? 0 : (dist > 113 ? 113 : dist);
                          const bool valid = (MODE == 0) ? (dist >= 0 && selb) : (dist >= 0 && dist < WIN);
                          float s = p1[r] + bt[idx]; s = valid ? s : MASKED; p1[r] = s; mx = fmaxf(mx, s); }
                    }
                }
                if (MODE != 2 || pass == 0) {
                    mx = fmaxf(mx, __shfl_xor(mx, 32));
                    const float mn = fmaxf(m, mx), alpha = __builtin_amdgcn_exp2f(m - mn); m = mn;
                    const float sub = lane_on ? mn : 1e30f;
                    float ls = 0.f;
#pragma unroll
                    for (int r = 0; r < 16; ++r) { p0[r] = __builtin_amdgcn_exp2f(p0[r] - sub); p1[r] = __builtin_amdgcn_exp2f(p1[r] - sub); ls += p0[r] + p1[r]; }
                    l = l * alpha + ls;
                    if (MODE != 2) {
                        if (__any(alpha < 1.f)) {
#pragma unroll
                            for (int d = 0; d < 4; ++d)
#pragma unroll
                                for (int e = 0; e < 16; ++e) o[d][e] *= alpha;
                        }
                    }
                } else {
#pragma unroll
                    for (int r = 0; r < 16; ++r) { p0[r] = __builtin_amdgcn_exp2f(p0[r] - m) * invl; p1[r] = __builtin_amdgcn_exp2f(p1[r] - m) * invl; }
                    LAS float* imp = (LAS float*)(lds + IMP_OFF) + (size_t)((half * 4 + hh) * 64) * 33 + ql;
#pragma unroll
                    for (int k = 0; k < 4; ++k) {
                        const int jj0 = 16 * j + 2 * k + hi, jj1 = jj0 + 8;
                        const float G0 = (p0[4 * k] + p0[4 * k + 1]) + (p0[4 * k + 2] + p0[4 * k + 3]);
                        const float G1 = (p1[4 * k] + p1[4 * k + 1]) + (p1[4 * k + 2] + p1[4 * k + 3]);
                        LADD(imp + jj0 * 33, G0); LADD(imp + jj1 * 33, G1);
                        LADD(imp + (jj0 + 1) * 33, p0[4 * k + 3]);
                        if (jj1 + 1 < 64) LADD(imp + (jj1 + 1) * 33, p1[4 * k + 3]);
                    }
                }
                if (MODE != 2 || pass == 1) {
                    bf16x8 pf[4];
#pragma unroll
                    for (int s = 0; s < 4; ++s) {
                        const int rb = 8 * (s & 1);
                        unsigned w[4];
#pragma unroll
                        for (int e = 0; e < 4; ++e) w[e] = (s < 2) ? cvtpk(p0[rb + 2 * e], p0[rb + 2 * e + 1]) : cvtpk(p1[rb + 2 * e], p1[rb + 2 * e + 1]);
                        v4u wv; wv.x = w[0]; wv.y = w[1]; wv.z = w[2]; wv.w = w[3];
                        pf[s] = __builtin_bit_cast(bf16x8, wv);
                    }
                    pv_tile(o, (lcp)(lds + VB0 + cur * 16384), pf, lane);
                }
            }
            if (more) tile_store(lds, cur ^ 1, R, tid);
            __syncthreads();
        }
        if (MODE == 2 && pass == 0) { const float lt = l + __shfl_xor(l, 32); invl = lt > 0.f ? 1.f / lt : 0.f; }
    }
    if (MODE != 2) { const float lt = l + __shfl_xor(l, 32); invl = 1.f / lt; }
    {
        const size_t ob = row * 1024 + head * HD + 4 * hi;
        float g0 = 0.f, g1 = 0.f, g2 = 0.f;
        if (MODE == 0) { const float* gr = P.gates + row * 24 + head * 3; g0 = gr[0]; g1 = gr[1]; g2 = gr[2]; }
#pragma unroll
        for (int db = 0; db < 4; ++db)
#pragma unroll
            for (int k = 0; k < 4; ++k) {
                float v0 = o[db][4 * k], v1 = o[db][4 * k + 1], v2 = o[db][4 * k + 2], v3 = o[db][4 * k + 3];
                if (MODE != 2) { v0 *= invl; v1 *= invl; v2 *= invl; v3 *= invl; }
                const size_t off = ob + 32 * db + 8 * k;
                if (MODE == 0) {
                    const unsigned long long c8 = *(const GAS unsigned long long*)(P.OC + off), w8 = *(const GAS unsigned long long*)(P.OW + off);
                    float r0 = g0 * bf2f((unsigned short)c8) + g1 * v0; r0 = r0 + g2 * bf2f((unsigned short)w8);
                    float r1 = g0 * bf2f((unsigned short)(c8 >> 16)) + g1 * v1; r1 = r1 + g2 * bf2f((unsigned short)(w8 >> 16));
                    float r2 = g0 * bf2f((unsigned short)(c8 >> 32)) + g1 * v2; r2 = r2 + g2 * bf2f((unsigned short)(w8 >> 32));
                    float r3 = g0 * bf2f((unsigned short)(c8 >> 48)) + g1 * v3; r3 = r3 + g2 * bf2f((unsigned short)(w8 >> 48));
                    *(GAS unsigned long long*)(P.AO + row * 2048 + head * HD + 4 * hi + 32 * db + 8 * k) = (unsigned long long)cvtpk(r0, r1) | ((unsigned long long)cvtpk(r2, r3) << 32);
                } else {
                    bf16* dst = (MODE == 1 ? P.OW : P.OC) + off;
                    *(GAS unsigned long long*)dst = (unsigned long long)cvtpk(v0, v1) | ((unsigned long long)cvtpk(v2, v3) << 32);
                }
            }
    }
    if (MODE == 2) {
        __syncthreads();
        const LAS float* impb = (const LAS float*)(lds + IMP_OFF);
#pragma unroll 1
        for (int qi = 0; qi < 8; ++qi) {
            const int qidx = wave * 8 + qi, hf = qidx >> 5, q_ = qidx & 31, tt = (hf ? qB0 : qA0) + q_, cur = tt >> 6, jj = lane;
            float v = 0.f;
#pragma unroll
            for (int h_ = 0; h_ < 4; ++h_) v += impb[((hf * 4 + h_) * 64 + jj) * 33 + q_];
            if (jj == 0 || jj == cur || jj == cur - 1) v = FORCEV;
            if (jj * 64 > tt) v = NEGV;
            const unsigned uk = v < 0.f ? 0u : __float_as_uint(v) + 1u;
            unsigned long long M = ~0ull; int need = TOPK;
#pragma unroll 1
            for (int bit = 31; bit >= 0; --bit) {
                const unsigned long long hiM = __ballot((uk >> bit) & 1u) & M; const int c = __popcll(hiM);
                if (c >= need) M = hiM; else { need -= c; M &= ~hiM; }
            }
            const unsigned ukT = (unsigned)__builtin_amdgcn_readlane((int)uk, __builtin_ctzll(M));
            unsigned long long mk = __ballot(uk > ukT);
            for (int n_ = 0; n_ < need; ++n_) { const unsigned long long low = M & (~M + 1ull); mk |= low; M &= ~low; }
            if (lane == 0) P.selm_out[(size_t)bg * T_ + tt] = mk;
        }
    }
    __syncthreads();
}
}

#ifndef REPEAT_MASK
#define REPEAT_MASK 0
#endif
struct Args { const float* in[16]; float* out; unsigned char* ws; int ph_lo, ph_hi, li, pad; };

__global__ void __launch_bounds__(NWAVES * 64, 2) mega_fwd(Args args) {
    extern __shared__ __attribute__((aligned(16))) unsigned char lds_raw[];
    LAS unsigned char* lds = (LAS unsigned char*)lds_raw;
    volatile LAS unsigned* MISC = (volatile LAS unsigned*)(lds + MISC_OFF);
    const int tid = threadIdx.x, lane = tid & 63, wave = __builtin_amdgcn_readfirstlane(tid >> 6);
    const int G = gridDim.x; const int bx = blockIdx.x;
    const int vcu = (G % 8 == 0) ? (bx % 8) * (G / 8) + bx / 8 : bx;
    unsigned char* ws = args.ws;
    const float* x = args.in[0]; const float* w_in = args.in[1]; const float* pe = args.in[2];
    const float* wk1 = args.in[3]; const float* wk2 = args.in[4]; const float* wv1 = args.in[5]; const float* wv2 = args.in[6];
    const float* conv_w = args.in[7]; const float* w_o = args.in[9]; const float* w_up = args.in[10]; const float* w_down = args.in[11];
    const float* g_pre_mix = args.in[12]; const float* g_post_mix = args.in[13]; const float* g_pre_ffn = args.in[14]; const float* g_post_ffn = args.in[15];
    float* out = args.out;
    bf16* WinT = (bf16*)(ws + WS_WIN); bf16* WoT = (bf16*)(ws + WS_WO); bf16* WupT = (bf16*)(ws + WS_WUP); bf16* WdnT = (bf16*)(ws + WS_WDN);
    bf16* W1T = (bf16*)(ws + WS_W1); bf16* Hb = (bf16*)(ws + WS_H); bf16* Qb = (bf16*)(ws + WS_Q); bf16* KVb = (bf16*)(ws + WS_KV);
    bf16* C3b = (bf16*)(ws + WS_C3); bf16* Ub = (bf16*)(ws + WS_U); float* Fb = (float*)(ws + WS_F); float* SLAB = (float*)(ws + WS_SLAB);
    const float* rel_bias = args.in[8]; unsigned long long* SELM = (unsigned long long*)(ws + WS_SELM); bf16* OCb = (bf16*)(ws + WS_OC); bf16* OWb = (bf16*)(ws + WS_OW);
    float* PEB = (float*)(ws + WS_PEB); float* GATES = (float*)(ws + WS_GATES); bf16* KCMP = (bf16*)(ws + WS_KCMP); bf16* VCMP = (bf16*)(ws + WS_VCMP);

    for (int u = tid; u < (LDS_BYTES - LDSCTL_OFF) / 4; u += NWAVES * 64) ((LAS unsigned*)(lds + LDSCTL_OFF))[u] = 0u;
    __syncthreads();
    XcdBarrier bar = xcd_barrier_post((unsigned*)(ws + WS_CTL) + 1024 + args.li * 4096, MISC + 8);
    const int lo = args.ph_lo, hi = args.ph_hi;
#define IN(k) (lo <= (k) && (k) < hi)
#define BOTH(k) (IN(k) && IN((k) + 1))
    const int gw = vcu * NWAVES + wave, NGW = G * NWAVES;

    if (IN(0)) for (int rep_ = 0; rep_ < (((REPEAT_MASK) >> 0) & 1) + 1; ++rep_) {
        LAS float* scr = (LAS float*)(lds + wave * 16640);
        constexpr int I_IN = 32 * (NQT / 64), I_O = 32 * 32, I_UP = 32 * 128, I_DN = 128 * 32, I_C1 = 64 * 4;
        constexpr int NITEMS = I_IN + I_O + I_UP + I_DN + 2 * I_C1;
        for (int it = gw; it < NITEMS; it += NGW) {
            int r = it;
            if (r < I_IN) { p0_transpose_item(w_in, INW, D_, NQT / 64, WinT, scr, r, lane, true); continue; } r -= I_IN;
            if (r < I_O) { p0_transpose_item(w_o, D_, 2048, 32, WoT, scr, r, lane, false); continue; } r -= I_O;
            if (r < I_UP) { p0_transpose_item(w_up, DFF, D_, 128, WupT, scr, r, lane, false); continue; } r -= I_UP;
            if (r < I_DN) { p0_transpose_item(w_down, D_, DFF, 32, WdnT, scr, r, lane, false); continue; } r -= I_DN;
            if (r < I_C1) { p0_transpose_item(wk1, 256, 4096, 4, W1T, scr, r, lane, false); continue; } r -= I_C1;
            p0_transpose_item(wv1, 256, 4096, 4, W1T + (size_t)256 * 4096, scr, r, lane, false);
        }
        for (int m = gw; m < M_; m += NGW) rms_row_to_bf16(x + (size_t)m * D_, g_pre_mix, Hb + (size_t)m * D_, lane);
        for (int it = gw; it < 256; it += NGW) {
            const int kv = it >> 7, ch = (it >> 2) & 31, hg = it & 3; const float* w1 = kv ? wv1 : wk1;
            float s = 0.f;
            for (int k = ch * 128; k < ch * 128 + 128; ++k) s += pe[k] * w1[(size_t)k * 256 + hg * 64 + lane];
            PEB[(kv * 32 + ch) * 256 + hg * 64 + lane] = s;
        }
        if (BOTH(0)) xcd_barrier(bar);
    }

    if (IN(1)) for (int rep_ = 0; rep_ < (((REPEAT_MASK) >> 1) & 1) + 1; ++rep_) {
        pg8::Gemm g{Hb, WinT, M_, NQT, D_, D_, D_}; pg8::StaticOrder S; S.init(M_, NQT, G, bx);
        pg8::EpiInProj E{Qb, KVb, C3b, GATES, QSCALE};
        pg8::gemm_phase<pg8::EpiInProj, pg8::StaticOrder, true, true>(lds, g, S, E);
        if (BOTH(1)) xcd_barrier(bar);
    }

    if (IN(2)) for (int rep_ = 0; rep_ < (((REPEAT_MASK) >> 2) & 1) + 1; ++rep_) {
        {
            const bool has = vcu < 64; const int kv = (vcu >> 5) & 1, ch = (vcu >> 2) & 7, pm = vcu & 3;
            pg8::Gemm g{KVb + (size_t)kv * KVSZ + ch * 512, W1T + (size_t)kv * 256 * 4096 + ch * 512, 1024, 256, 512, 2048, 4096};
            pg8::OneUnit S{has, {pm, 0}};
            pg8::EpiF32 E{SLAB + (size_t)(kv * 8 + ch) * 1024 * 256, 256};
            pg8::gemm_phase<pg8::EpiF32, pg8::OneUnit, false, true>(lds, g, S, E);
        }
        {
            const bf16* CH = C3b; const bf16* CB = C3b + (size_t)M_ * 1024; const bf16* CC = C3b + (size_t)2 * M_ * 1024;
            const int cv0 = G > 64 ? 64 : 0, cvn = G - cv0;
            if (vcu >= cv0)
            for (int idx = (vcu - cv0) * 512 + tid; idx < M_ * 128; idx += cvn * 512) {
                const int r = idx >> 7, c8 = (idx & 127) * 8, t = r & 4095; const size_t o = (size_t)r * 1024 + c8;
                const v4u h2 = *(const GAS v4u*)(CH + o), c2 = *(const GAS v4u*)(CC + o), bb = *(const GAS v4u*)(CB + o);
                v4u h1 = {0, 0, 0, 0}, c1 = {0, 0, 0, 0}, h0 = {0, 0, 0, 0}, c0 = {0, 0, 0, 0};
                if (t >= 1) { h1 = *(const GAS v4u*)(CH + o - 1024); c1 = *(const GAS v4u*)(CC + o - 1024); }
                if (t >= 2) { h0 = *(const GAS v4u*)(CH + o - 2048); c0 = *(const GAS v4u*)(CC + o - 2048); }
                unsigned ow[4];
#pragma unroll
                for (int e = 0; e < 4; ++e) {
                    float res[2];
#pragma unroll
                    for (int p = 0; p < 2; ++p) {
                        const int sh = 16 * p; const int col = c8 + 2 * e + p;
                        const float u2 = bf2f((unsigned short)(c2[e] >> sh)) * bf2f((unsigned short)(h2[e] >> sh));
                        const float u1 = bf2f((unsigned short)(c1[e] >> sh)) * bf2f((unsigned short)(h1[e] >> sh));
                        const float u0 = bf2f((unsigned short)(c0[e] >> sh)) * bf2f((unsigned short)(h0[e] >> sh));
                        float y = conv_w[col] * u0; y = y + conv_w[1024 + col] * u1; y = y + conv_w[2048 + col] * u2;
                        res[p] = bf2f((unsigned short)(bb[e] >> sh)) * y;
                    }
                    ow[e] = pk2(res[0], res[1]);
                }
                v4u ov; ov.x = ow[0]; ov.y = ow[1]; ov.z = ow[2]; ov.w = ow[3];
                *(GAS v4u*)(Hb + (size_t)r * 2048 + 1024 + c8) = ov;
            }
        }
        {
            att::AttnBufs P{Qb, KVb + 4 * KVSZ, KVb + 5 * KVSZ, T_, rel_bias, SELM, SELM, GATES, OCb, OWb, Hb};
            for (int it = vcu; it < 256; it += G) { const int bg = it >> 6, qb = it & 63; att::attn_item<1>(lds, P, bg >> 1, bg & 1, 64 * qb, 64 * qb + 32, tid, lane, wave); }
        }
        if (BOTH(2)) xcd_barrier(bar);
    }

    if (IN(3)) for (int rep_ = 0; rep_ < (((REPEAT_MASK) >> 3) & 1) + 1; ++rep_) {
        LAS float* hid = (LAS float*)lds;
        LAS f32x4* part = (LAS f32x4*)(lds + 8192);
        for (int it = vcu; it < 256; it += G) {
            const int kv = it >> 7, bg = (it >> 5) & 3, sl = it & 31, r0 = bg * 256 + sl * 8;
            const float* w2 = kv ? wv2 : wk2; bf16* outp = kv ? VCMP : KCMP;
            {
                const int h = tid & 255; float pb = 0.f;
#pragma unroll 8
                for (int c2 = 0; c2 < 32; ++c2) pb += PEB[(kv * 32 + c2) * 256 + h];
#pragma unroll
                for (int i = 0; i < 4; ++i) { const int e = tid + 512 * i, r = e >> 8; float sv[8];
#pragma unroll
                    for (int ch = 0; ch < 8; ++ch) sv[ch] = SLAB[((size_t)(kv * 8 + ch) * 1024 + r0 + r) * 256 + h];
                    float s_ = ((sv[0] + sv[1]) + (sv[2] + sv[3])) + ((sv[4] + sv[5]) + (sv[6] + sv[7])); s_ += pb; hid[e] = s_ / (1.f + __expf(-s_)); }
            }
            __syncthreads();
            {
                const int e4 = (tid & 31) * 4, r = (tid >> 5) & 7, kh = tid >> 8;
                f32x4 acc = {0.f, 0.f, 0.f, 0.f};
#pragma unroll 16
                for (int h = kh * 128; h < kh * 128 + 128; ++h) { const f32x4 w = *(const GAS f32x4*)(w2 + h * 128 + e4); const float a = hid[r * 256 + h];
                    acc.x += a * w.x; acc.y += a * w.y; acc.z += a * w.z; acc.w += a * w.w; }
                if (kh) part[tid - 256] = acc;
                __syncthreads();
                if (!kh) { const f32x4 o = acc + part[tid]; const int c = sl * 8 + r;
                    const unsigned long long pk = (c < NCMP) ? ((unsigned long long)pk2(o.x, o.y) | ((unsigned long long)pk2(o.z, o.w) << 32)) : 0ull;
                    *(GAS unsigned long long*)(outp + ((size_t)bg * 256 + c) * 128 + e4) = pk; }
            }
            __syncthreads();
        }
        if (BOTH(3)) xcd_barrier(bar);
    }

    if (IN(4)) for (int rep_ = 0; rep_ < (((REPEAT_MASK) >> 4) & 1) + 1; ++rep_) {
        att::AttnBufs P{Qb, KCMP, VCMP, 256, rel_bias, SELM, SELM, GATES, OCb, OWb, Hb};
        for (int it = vcu; it < 256; it += G) { const int bg = it >> 6, qb = it & 63; att::attn_item<2>(lds, P, bg >> 1, bg & 1, 64 * qb, 64 * qb + 32, tid, lane, wave); }
        if (BOTH(4)) xcd_barrier(bar);
    }
    if (IN(5)) for (int rep_ = 0; rep_ < (((REPEAT_MASK) >> 5) & 1) + 1; ++rep_) {
        att::AttnBufs P{Qb, KVb + 2 * KVSZ, KVb + 3 * KVSZ, T_, rel_bias, SELM, SELM, GATES, OCb, OWb, Hb};
        for (int it = vcu; it < 256; it += G) { const int bg = it >> 6, pp = it & 63; att::attn_item<0>(lds, P, bg >> 1, bg & 1, 32 * pp, 32 * (127 - pp), tid, lane, wave); }
        if (BOTH(5)) xcd_barrier(bar);
    }

    if (IN(6)) for (int rep_ = 0; rep_ < (((REPEAT_MASK) >> 6) & 1) + 1; ++rep_) {
        pg8::Gemm g{Hb, WoT, M_, D_, 2048, 2048, 2048}; pg8::StaticOrder S; S.init(M_, D_, G, bx);
        pg8::EpiF32 E{out, D_};
        pg8::gemm_phase<pg8::EpiF32, pg8::StaticOrder, true, true>(lds, g, S, E);
        if (BOTH(6)) xcd_barrier(bar);
    }

    if (IN(7)) for (int rep_ = 0; rep_ < (((REPEAT_MASK) >> 7) & 1) + 1; ++rep_) {
        for (int m = gw; m < M_; m += NGW) {
            GAS f32x4* mr = (GAS f32x4*)(out + (size_t)m * D_) + lane; const GAS f32x4* xr = (const GAS f32x4*)(x + (size_t)m * D_) + lane;
            const GAS f32x4* g1 = (const GAS f32x4*)g_post_mix + lane; const GAS f32x4* g2 = (const GAS f32x4*)g_pre_ffn + lane;
            f32x4 v[8]; float s = 0.f;
#pragma unroll
            for (int j = 0; j < 8; ++j) { v[j] = mr[64 * j]; s += (v[j].x * v[j].x + v[j].y * v[j].y) + (v[j].z * v[j].z + v[j].w * v[j].w); }
            const float r1 = rsqrtf(wave_sum(s) * (1.f / D_) + EPS); float s2 = 0.f;
#pragma unroll
            for (int j = 0; j < 8; ++j) { const f32x4 g = g1[64 * j], xx = xr[64 * j];
                v[j].x = xx.x + (v[j].x * r1) * g.x; v[j].y = xx.y + (v[j].y * r1) * g.y; v[j].z = xx.z + (v[j].z * r1) * g.z; v[j].w = xx.w + (v[j].w * r1) * g.w;
                mr[64 * j] = v[j]; s2 += (v[j].x * v[j].x + v[j].y * v[j].y) + (v[j].z * v[j].z + v[j].w * v[j].w); }
            const float r2 = rsqrtf(wave_sum(s2) * (1.f / D_) + EPS);
            GAS unsigned long long* o8 = (GAS unsigned long long*)(Hb + (size_t)m * D_) + lane;
#pragma unroll
            for (int j = 0; j < 8; ++j) { const f32x4 g = g2[64 * j];
                o8[64 * j] = (unsigned long long)pk2((v[j].x * r2) * g.x, (v[j].y * r2) * g.y) | ((unsigned long long)pk2((v[j].z * r2) * g.z, (v[j].w * r2) * g.w) << 32); }
        }
        if (BOTH(7)) xcd_barrier(bar);
    }

    if (IN(8)) for (int rep_ = 0; rep_ < (((REPEAT_MASK) >> 8) & 1) + 1; ++rep_) {
        pg8::Gemm g{Hb, WupT, M_, DFF, D_, D_, D_}; pg8::StaticOrder S; S.init(M_, DFF, G, bx);
        pg8::EpiRelu2Bf16 E{Ub, DFF};
        pg8::gemm_phase<pg8::EpiRelu2Bf16, pg8::StaticOrder, true, true>(lds, g, S, E);
        if (BOTH(8)) xcd_barrier(bar);
    }

    if (IN(9)) for (int rep_ = 0; rep_ < (((REPEAT_MASK) >> 9) & 1) + 1; ++rep_) {
        pg8::Gemm g{Ub, WdnT, M_, D_, DFF, DFF, DFF}; pg8::StaticOrder S; S.init(M_, D_, G, bx);
        pg8::EpiF32 E{Fb, D_};
        pg8::gemm_phase<pg8::EpiF32, pg8::StaticOrder, true, true>(lds, g, S, E);
        if (BOTH(9)) xcd_barrier(bar);
    }

    if (IN(10)) for (int rep_ = 0; rep_ < (((REPEAT_MASK) >> 10) & 1) + 1; ++rep_) {
        for (int m = gw; m < M_; m += NGW) {
            const GAS f32x4* fr = (const GAS f32x4*)(Fb + (size_t)m * D_) + lane; GAS f32x4* orow = (GAS f32x4*)(out + (size_t)m * D_) + lane;
            const GAS f32x4* g1 = (const GAS f32x4*)g_post_ffn + lane;
            f32x4 v[8]; float s = 0.f;
#pragma unroll
            for (int j = 0; j < 8; ++j) { v[j] = fr[64 * j]; s += (v[j].x * v[j].x + v[j].y * v[j].y) + (v[j].z * v[j].z + v[j].w * v[j].w); }
            const float r1 = rsqrtf(wave_sum(s) * (1.f / D_) + EPS);
#pragma unroll
            for (int j = 0; j < 8; ++j) { const f32x4 g = g1[64 * j]; f32x4 xx = orow[64 * j];
                xx.x = xx.x + (v[j].x * r1) * g.x; xx.y = xx.y + (v[j].y * r1) * g.y; xx.z = xx.z + (v[j].z * r1) * g.z; xx.w = xx.w + (v[j].w * r1) * g.w;
                orow[64 * j] = xx; }
        }
    }
#undef IN
#undef BOTH
}

__device__ __forceinline__ float block_max(float v, float* red) {
  for (int o = 32; o > 0; o >>= 1) v = fmaxf(v, __shfl_xor(v, o));
  __syncthreads();
  if ((threadIdx.x & 63) == 0) red[threadIdx.x >> 6] = v;
  __syncthreads();
  return fmaxf(fmaxf(red[0], red[1]), fmaxf(red[2], red[3]));
}
__device__ __forceinline__ float block_sum(float v, float* red) {
  for (int o = 32; o > 0; o >>= 1) v += __shfl_xor(v, o);
  __syncthreads();
  if ((threadIdx.x & 63) == 0) red[threadIdx.x >> 6] = v;
  __syncthreads();
  return (red[0] + red[1]) + (red[2] + red[3]);
}
__global__ __launch_bounds__(256) void cmp_attn_ref(const bf16* Qb, const bf16* KCMP, const bf16* VCMP, const float* rel_bias, bf16* OC, unsigned long long* selmask) {
  const int id = blockIdx.x, t = id % T_, g = (id / T_) % NKV, b = id / (T_ * NKV);
  const int tid = threadIdx.x;
  const size_t row = (size_t)b * T_ + t;
  __shared__ float q[4][HD];
  __shared__ float p[4][256];
  __shared__ float red[4];
  for (int i = tid; i < 512; i += 256) q[i >> 7][i & 127] = bf2f(Qb[row * 1024 + (g * 4 + (i >> 7)) * HD + (i & 127)]);
  __syncthreads();
  const int c = tid;
  const bool valid = (c < NCMP) && (16 * c + 31 <= t);
  float s[4] = {NEGV, NEGV, NEGV, NEGV};
  if (valid) {
    const int bk = rel_bucket(t - (16 * c + 31));
    const bf16* kr = KCMP + ((size_t)(b * NKV + g) * 256 + c) * HD;
    float a0 = 0.f, a1 = 0.f, a2 = 0.f, a3 = 0.f;
    for (int d = 0; d < HD; ++d) { const float kvv = bf2f(kr[d]); a0 += q[0][d] * kvv; a1 += q[1][d] * kvv; a2 += q[2][d] * kvv; a3 += q[3][d] * kvv; }
    s[0] = a0 + rel_bias[(g * 4 + 0) * 32 + bk] * LOG2E;
    s[1] = a1 + rel_bias[(g * 4 + 1) * 32 + bk] * LOG2E;
    s[2] = a2 + rel_bias[(g * 4 + 2) * 32 + bk] * LOG2E;
    s[3] = a3 + rel_bias[(g * 4 + 3) * 32 + bk] * LOG2E;
  }
#pragma unroll
  for (int h = 0; h < 4; ++h) {
    const float m = block_max(s[h], red);
    const float e = valid ? exp2f(s[h] - m) : 0.f;
    const float l = block_sum(e, red);
    p[h][c] = valid ? e / l : 0.f;
  }
  __syncthreads();
  {
    const int d = tid & 127, hp = tid >> 7;
    const bf16* vb = VCMP + (size_t)(b * NKV + g) * 256 * HD;
    float o0 = 0.f, o1 = 0.f;
    for (int cc = 0; cc < NCMP; ++cc) { const float vv = bf2f(vb[cc * HD + d]); o0 += p[hp * 2][cc] * vv; o1 += p[hp * 2 + 1][cc] * vv; }
    const int h0 = g * 4 + hp * 2;
    OC[row * 1024 + h0 * HD + d] = (bf16)f2bf(o0);
    OC[row * 1024 + (h0 + 1) * HD + d] = (bf16)f2bf(o1);
  }
  if (tid < 64) {
    const int j = tid, cur = t >> 6;
    float v = 0.f;
    for (int h = 0; h < 4; ++h)
      for (int cc = 4 * j - 1; cc <= 4 * j + 3; ++cc)
        if (cc >= 0 && cc < NCMP) v += p[h][cc];
    if (j == 0 || j == cur || j == cur - 1) v = FORCEV;
    if (j * 64 > t) v = NEGV;
    int rank = 0;
    for (int i = 0; i < 64; ++i) { const float vi = __shfl(v, i); rank += (vi > v || (vi == v && i < j)) ? 1 : 0; }
    const unsigned long long mk = __ballot(rank < TOPK);
    if (tid == 0) selmask[(size_t)(b * NKV + g) * T_ + t] = mk;
  }
}
template <int MODE>
__global__ __launch_bounds__(256) void attn_ref(const bf16* Qb, const bf16* KVb, const float* rel_bias, const unsigned long long* selmask, const float* GATES,
                                                const bf16* OC, bf16* OW, bf16* AO, int ao_ld) {
  const int id = blockIdx.x, t = id % T_, g = (id / T_) % NKV, b = id / (T_ * NKV);
  const int tid = threadIdx.x;
  const size_t row = (size_t)b * T_ + t;
  __shared__ float q[4][HD];
  __shared__ float sc[4][1024];
  __shared__ float red[4];
  __shared__ int blist[16];
  __shared__ int nblk;
  const bf16* Kb = KVb + (size_t)(MODE ? 4 : 2) * KVSZ + (size_t)(b * NKV + g) * T_ * HD;
  const bf16* Vb = KVb + (size_t)(MODE ? 5 : 3) * KVSZ + (size_t)(b * NKV + g) * T_ * HD;
  for (int i = tid; i < 512; i += 256) q[i >> 7][i & 127] = bf2f(Qb[row * 1024 + (g * 4 + (i >> 7)) * HD + (i & 127)]);
  if (MODE == 0 && tid == 0) {
    const unsigned long long mk = selmask[(size_t)(b * NKV + g) * T_ + t];
    int n = 0;
    for (int j = 0; j < NSEL; ++j) if (((mk >> j) & 1ull) && j * 64 <= t && n < 16) blist[n++] = j;
    nblk = n;
  }
  __syncthreads();
  const int kstart = t - (WIN - 1) < 0 ? 0 : t - (WIN - 1);
  const int nkeys = MODE ? (t - kstart + 1) : nblk * 64;
  for (int i = tid; i < nkeys; i += 256) {
    const int pos = MODE ? (kstart + i) : (blist[i >> 6] * 64 + (i & 63));
    const bool valid = pos <= t;
    float s0 = NEGV, s1 = NEGV, s2 = NEGV, s3 = NEGV;
    if (valid) {
      const bf16* kr = Kb + (size_t)pos * HD;
      float a0 = 0.f, a1 = 0.f, a2 = 0.f, a3 = 0.f;
      for (int d = 0; d < HD; ++d) { const float kvv = bf2f(kr[d]); a0 += q[0][d] * kvv; a1 += q[1][d] * kvv; a2 += q[2][d] * kvv; a3 += q[3][d] * kvv; }
      const int bk = rel_bucket(t - pos);
      s0 = a0 + rel_bias[(g * 4 + 0) * 32 + bk] * LOG2E;
      s1 = a1 + rel_bias[(g * 4 + 1) * 32 + bk] * LOG2E;
      s2 = a2 + rel_bias[(g * 4 + 2) * 32 + bk] * LOG2E;
      s3 = a3 + rel_bias[(g * 4 + 3) * 32 + bk] * LOG2E;
    }
    sc[0][i] = s0; sc[1][i] = s1; sc[2][i] = s2; sc[3][i] = s3;
  }
  __syncthreads();
#pragma unroll
  for (int h = 0; h < 4; ++h) {
    float m = NEGV;
    for (int i = tid; i < nkeys; i += 256) m = fmaxf(m, sc[h][i]);
    m = block_max(m, red);
    float l = 0.f;
    for (int i = tid; i < nkeys; i += 256) { const float sv = sc[h][i]; const float e = (sv > -1e29f) ? exp2f(sv - m) : 0.f; sc[h][i] = e; l += e; }
    l = block_sum(l, red);
    const float inv = 1.f / l;
    for (int i = tid; i < nkeys; i += 256) sc[h][i] *= inv;
  }
  __syncthreads();
  {
    const int d = tid & 127, hp = tid >> 7;
    float o0 = 0.f, o1 = 0.f;
    for (int i = 0; i < nkeys; ++i) {
      const int pos = MODE ? (kstart + i) : (blist[i >> 6] * 64 + (i & 63));
      if (pos <= t) { const float vv = bf2f(Vb[(size_t)pos * HD + d]); o0 += sc[hp * 2][i] * vv; o1 += sc[hp * 2 + 1][i] * vv; }
    }
    const int h0 = g * 4 + hp * 2;
    const size_t i0 = row * 1024 + h0 * HD + d, i1 = row * 1024 + (h0 + 1) * HD + d;
    if (MODE) { OW[i0] = (bf16)f2bf(o0); OW[i1] = (bf16)f2bf(o1); }
    else {
      const float* gr = GATES + row * 24;
      float r0 = gr[h0 * 3 + 0] * bf2f(OC[i0]) + gr[h0 * 3 + 1] * o0; r0 = r0 + gr[h0 * 3 + 2] * bf2f(OW[i0]);
      float r1 = gr[(h0 + 1) * 3 + 0] * bf2f(OC[i1]) + gr[(h0 + 1) * 3 + 1] * o1; r1 = r1 + gr[(h0 + 1) * 3 + 2] * bf2f(OW[i1]);
      AO[row * ao_ld + h0 * HD + d] = (bf16)f2bf(r0);
      AO[row * ao_ld + (h0 + 1) * HD + d] = (bf16)f2bf(r1);
    }
  }
}

static void launch_mega(const Args& a0, int lo, int hi, int li, int grid, hipStream_t stream) {
    Args a = a0; a.ph_lo = lo; a.ph_hi = hi; a.li = li; a.pad = 0;
    void* params[] = {&a};
    hipError_t e = hipLaunchCooperativeKernel((const void*)mega_fwd, dim3(grid), dim3(NWAVES * 64), params, LDS_BYTES, stream);
    if (e != hipSuccess) fprintf(stderr, "kernel_launch: cooperative launch failed: %s (grid %d)\n", hipGetErrorString(e), grid);
}


#ifndef DEBUG_CHECK
#define DEBUG_CHECK 0
#endif
#if DEBUG_CHECK
__global__ void cmp_bf16_k(const bf16* a, int lda, const bf16* b, int ldb, int rows, int cols, unsigned* maxerr) {
    float e = 0.f;
    for (size_t i = (size_t)blockIdx.x * blockDim.x + threadIdx.x; i < (size_t)rows * cols; i += (size_t)gridDim.x * blockDim.x) {
        const int r = (int)(i / cols), c = (int)(i % cols);
        const float d = fabsf(bf2f(a[(size_t)r * lda + c]) - bf2f(b[(size_t)r * ldb + c]));
        e = fmaxf(e, d == d ? d : 1e9f);
    }
    for (int o = 32; o > 0; o >>= 1) e = fmaxf(e, __shfl_xor(e, o));
    if ((threadIdx.x & 63) == 0) atomicMax(maxerr, __float_as_uint(e));
}
__global__ void cmp_mask_k(const unsigned long long* a, const unsigned long long* b, int n, unsigned* cnt) {
    const int i = blockIdx.x * blockDim.x + threadIdx.x;
    if (i < n) { const int t = i & 4095; const int cur = t >> 6; const unsigned long long causal = cur >= 63 ? ~0ull : ((1ull << (cur + 1)) - 1ull);
        if ((a[i] & causal) != (b[i] & causal)) atomicAdd(cnt, 1u); }
}
__global__ void flag_k(const unsigned* errs, float* out) {
    if (threadIdx.x == 0 && blockIdx.x == 0) {
        const float e1 = __uint_as_float(errs[0]), e2 = __uint_as_float(errs[1]), e4 = __uint_as_float(errs[3]); const unsigned n3 = errs[2];
        float code = 0.f, sev = 0.f; const float tol = 0.01f;
        if (e1 > tol) { code = 1.f; sev = e1 / tol; }
        else if (e2 > tol) { code = 2.f; sev = e2 / tol; }
        else if (n3 > 16u) { code = 3.f; sev = (float)n3 / 16.f; }
        else if (e4 > tol) { code = 4.f; sev = e4 / tol; }
        if (code > 0.f) { sev = sev > 9.f ? 9.f : sev; out[0] += 100.f * code + 10.f * floorf(sev); }
#if DEBUG_CHECK == 2
        out[0] += 1e4f * fmaxf(e1, fmaxf(e2, e4)); out[1] += (float)n3;
#endif
    }
}
#endif

extern "C" void kernel_launch(void* const* d_in, const int* in_sizes, int n_in, void* d_out, int out_size, void* d_ws, size_t ws_size, hipStream_t stream) {
    static int grid = 0;
    if (grid == 0) {
        if (n_in != 16 || ws_size < WS_END) { fprintf(stderr, "kernel_launch: unexpected n_in %d or ws_size %zu (< %zu)\n", n_in, ws_size, (size_t)WS_END); grid = -1; return; }
        int dev = 0, cus = 0, per_cu = 0;
        (void)hipGetDevice(&dev); (void)hipDeviceGetAttribute(&cus, hipDeviceAttributeMultiprocessorCount, dev);
        (void)hipFuncSetAttribute((const void*)mega_fwd, hipFuncAttributeMaxDynamicSharedMemorySize, LDS_BYTES);
        (void)hipOccupancyMaxActiveBlocksPerMultiprocessor(&per_cu, (const void*)mega_fwd, NWAVES * 64, LDS_BYTES);
        if (per_cu < 1) { fprintf(stderr, "kernel_launch: occupancy query says %d blocks per CU\n", per_cu); grid = -1; return; }
        grid = cus;
    }
    if (grid < 0) return;
    (void)hipMemsetAsync((char*)d_ws + WS_CTL, 0, CTL_ZERO_BYTES, stream);
    Args a{};
    for (int i = 0; i < 16; ++i) a.in[i] = (const float*)d_in[i];
    a.out = (float*)d_out; a.ws = (unsigned char*)d_ws;
#if DEBUG_CHECK
    unsigned char* ws = (unsigned char*)d_ws;
    const float* rel_bias = (const float*)d_in[8];
    unsigned* errs = (unsigned*)(ws + WS_CTL + 122880);
    bf16* TMP = (bf16*)(ws + WS_WIN);
    unsigned long long* SELMX = (unsigned long long*)(ws + WS_WIN + 20 * MiB);
    launch_mega(a, 0, 4, 0, grid, stream);
    attn_ref<1><<<B_ * NKV * T_, 256, 0, stream>>>((const bf16*)(ws + WS_Q), (const bf16*)(ws + WS_KV), rel_bias, (const unsigned long long*)(ws + WS_SELM),
                                                   (const float*)(ws + WS_GATES), (const bf16*)(ws + WS_OC), TMP, TMP, 1024);
    cmp_bf16_k<<<1024, 256, 0, stream>>>((const bf16*)(ws + WS_OW), 1024, TMP, 1024, M_, 1024, errs + 0);
    launch_mega(a, 4, 5, 1, grid, stream);
    cmp_attn_ref<<<B_ * NKV * T_, 256, 0, stream>>>((const bf16*)(ws + WS_Q), (const bf16*)(ws + WS_KCMP), (const bf16*)(ws + WS_VCMP), rel_bias, TMP, SELMX);
    cmp_bf16_k<<<1024, 256, 0, stream>>>((const bf16*)(ws + WS_OC), 1024, TMP, 1024, M_, 1024, errs + 1);
    cmp_mask_k<<<64, 256, 0, stream>>>((const unsigned long long*)(ws + WS_SELM), SELMX, 4 * T_, errs + 2);
    launch_mega(a, 5, 6, 2, grid, stream);
    attn_ref<0><<<B_ * NKV * T_, 256, 0, stream>>>((const bf16*)(ws + WS_Q), (const bf16*)(ws + WS_KV), rel_bias, (const unsigned long long*)(ws + WS_SELM),
                                                   (const float*)(ws + WS_GATES), (const bf16*)(ws + WS_OC), (bf16*)(ws + WS_OW), TMP, 1024);
    cmp_bf16_k<<<1024, 256, 0, stream>>>((const bf16*)(ws + WS_H), 2048, TMP, 1024, M_, 1024, errs + 3);
    launch_mega(a, 6, 11, 3, grid, stream);
    flag_k<<<1, 64, 0, stream>>>(errs, (float*)d_out);
#elif defined(SPLIT_A_HI)
    launch_mega(a, 0, SPLIT_A_HI, 0, grid, stream);
    launch_mega(a, SPLIT_B_LO, 11, 1, grid, stream);
#else
    launch_mega(a, 0, 11, 0, grid, stream);
#endif
}
```

```cpp
#include <hip/hip_runtime.h>
#include <cstdio>
#include <cstdint>
namespace pg8 {
#define PG8_LAS __attribute__((address_space(3)))
typedef unsigned short bf16_t;
typedef short bf16x8 __attribute__((ext_vector_type(8)));
typedef float f32x4 __attribute__((ext_vector_type(4)));
typedef unsigned u32x4 __attribute__((ext_vector_type(4)));
constexpr int BM = 256, BK = 64, HALF = 128, HTB = HALF * BK * 2  , STAGE_BYTES = 8 * HTB, NXCD = 8, WGM = 8;

__host__ __device__ __forceinline__ int lds_byte(int r, int c) { const int st = (r >> 4) * 2 + (c >> 5), rr = r & 15, cc = c & 31, ob = rr * 64 + cc * 2; return st * 1024 + (ob ^ (((ob >> 9) & 1) << 5)); }
__host__ __device__ __forceinline__ void stage_rc(int b, int& R, int& C) { const int st = b / 1024, sb = b % 1024, swz = sb ^ (((sb >> 9) & 1) << 5); R = (st >> 1) * 16 + swz / 64; C = (st & 1) * 32 + (swz % 64) / 2; }
__host__ __device__ __forceinline__ int perm32(int rho) { const int n = rho >> 4, i = rho & 15; return 8 * (i >> 2) + 4 * n + (i & 3); }

struct Unit { int pm, pn; };
struct Gemm { const bf16_t* A; const bf16_t* Bt; int M, N, K, lda, ldb; };

struct StaticOrder {
    int nM, nN, nwg, G, c;
    __host__ __device__ void init(int M, int N, int G_, int c_) { nM = M / BM; nN = N / BM; nwg = nM * nN; G = G_; c = c_; }
    __host__ __device__ bool next(int i, Unit& u) const {
        const long L = (long)i * G + c; if (L >= nwg) return false;
        int wgid = (int)L; { const int q = nwg / NXCD, r = nwg % NXCD, xcd = wgid % NXCD, off = wgid / NXCD; wgid = (xcd < r ? xcd * (q + 1) : r * (q + 1) + (xcd - r) * q) + off; }
        const int nig = WGM * nN, gid = wgid / nig, fm = gid * WGM, gsz = (nM - fm) < WGM ? (nM - fm) : WGM;
        u.pm = fm + ((wgid % nig) % gsz); u.pn = (wgid % nig) / gsz; return true;
    }
    __device__ __forceinline__ void a_ready(const Unit&) const {}
    __device__ __forceinline__ void done(const Unit&) const {}
};

__device__ __forceinline__ unsigned cvt_pk_bf16(float lo, float hi) { unsigned r; asm volatile("v_cvt_pk_bf16_f32 %0, %1, %2" : "=v"(r) : "v"(lo), "v"(hi)); return r; }
typedef float f32x2 __attribute__((ext_vector_type(2)));
struct EpiF32 {
    static constexpr bool PERM = false, AFTER_DRAIN = false;
    float* C; int ldc;
    __device__ __forceinline__ void operator()(const f32x4 (&acc)[2][2][4][2], const Unit& u, int wr, int wc, int fr, int fq) const {
        const int row0 = u.pm * BM + wr * 64 + fr, col0 = u.pn * BM + wc * 32 + 4 * fq;
#pragma unroll
        for (int ai = 0; ai < 2; ++ai)
#pragma unroll
            for (int m = 0; m < 4; ++m) { float* rowp = C + (size_t)(row0 + ai * HALF + m * 16) * ldc + col0;
#pragma unroll
                for (int bj = 0; bj < 2; ++bj)
#pragma unroll
                    for (int n = 0; n < 2; ++n) *(f32x4*)(rowp + bj * HALF + n * 16) = acc[ai][bj][m][n]; }
    }
};
struct EpiRelu2Bf16 {
    static constexpr bool PERM = true, AFTER_DRAIN = false;
    bf16_t* O; int ldc;
    __device__ __forceinline__ void operator()(const f32x4 (&acc)[2][2][4][2], const Unit& u, int wr, int wc, int fr, int fq) const {
        const int row0 = u.pm * BM + wr * 64 + fr, col0 = u.pn * BM + wc * 32 + 8 * fq;
#pragma unroll
        for (int ai = 0; ai < 2; ++ai)
#pragma unroll
            for (int m = 0; m < 4; ++m) { bf16_t* rowp = O + (size_t)(row0 + ai * HALF + m * 16) * ldc + col0;
#pragma unroll
                for (int bj = 0; bj < 2; ++bj) { f32x4 v0 = acc[ai][bj][m][0], v1 = acc[ai][bj][m][1];
#pragma unroll
                    for (int e = 0; e < 4; ++e) { v0[e] = v0[e] > 0.f ? v0[e] : 0.f; v1[e] = v1[e] > 0.f ? v1[e] : 0.f; }
                    v0 = v0 * v0; v1 = v1 * v1;
                    u32x4 w; w.x = cvt_pk_bf16(v0[0], v0[1]); w.y = cvt_pk_bf16(v0[2], v0[3]); w.z = cvt_pk_bf16(v1[0], v1[1]); w.w = cvt_pk_bf16(v1[2], v1[3]);
                    *(u32x4*)(rowp + bj * HALF) = w; } }
    }
};
struct EpiInProj {
    static constexpr bool PERM = true, AFTER_DRAIN = false;
    bf16_t* Q; bf16_t* KV; bf16_t* C3; float* gates; float qscale;
    __device__ __forceinline__ void operator()(const f32x4 (&acc)[2][2][4][2], const Unit& u, int wr, int wc, int fr, int fq) const {
        const int pn = u.pn;
        const int row0 = u.pm * BM + wr * 64 + fr, cc0 = wc * 32 + 8 * fq;
#pragma unroll
        for (int ai = 0; ai < 2; ++ai)
#pragma unroll
            for (int m = 0; m < 4; ++m) { const int r = row0 + ai * HALF + m * 16;
#pragma unroll
                for (int bj = 0; bj < 2; ++bj) { f32x4 v0 = acc[ai][bj][m][0], v1 = acc[ai][bj][m][1];
                    const int cc = cc0 + bj * HALF;
                    if (pn == 22) {
                        if (bj == 0 && cc < 24) {
#pragma unroll
                            for (int e = 0; e < 4; ++e) { gates[(size_t)r * 24 + cc + e] = 1.f / (1.f + __expf(-v0[e])); gates[(size_t)r * 24 + cc + 4 + e] = 1.f / (1.f + __expf(-v1[e])); }
                        }
                    } else {
                        bf16_t* dst;
                        if (pn < 4) { v0 = v0 * qscale; v1 = v1 * qscale; dst = Q + (size_t)r * 1024 + pn * 256 + cc; }
                        else if (pn < 10) { const int b = r >> 12, t = r & 4095; dst = KV + (size_t)(pn - 4) * (4 * 4096 * 128) + ((size_t)((b * 2 + bj) * 4096 + t)) * 128 + cc0; }
                        else { const int idx = (pn - 10) >> 2; dst = C3 + (size_t)idx * (8192 * 1024) + (size_t)r * 1024 + ((pn - 10) & 3) * 256 + cc; }
                        u32x4 w; w.x = cvt_pk_bf16(v0[0], v0[1]); w.y = cvt_pk_bf16(v0[2], v0[3]); w.z = cvt_pk_bf16(v1[0], v1[1]); w.w = cvt_pk_bf16(v1[2], v1[3]);
                        *(u32x4*)dst = w;
                    } } }
    }
};
struct OneUnit {
    bool has; Unit u;
    __device__ __forceinline__ bool next(int i, Unit& o) const { if (i == 0 && has) { o = u; return true; } return false; }
    __device__ __forceinline__ void a_ready(const Unit&) const {}
    __device__ __forceinline__ void done(const Unit&) const {}
};

template <class Epi, class Sched, bool ALIGN_EPI = false, bool SP2 = false>
__device__ __forceinline__ void gemm_phase(PG8_LAS unsigned char* lds, const Gemm g, const Sched& S, const Epi& E, int wave_) {
    const int wid = wave_, lane = (int)__builtin_amdgcn_mbcnt_hi(~0u, __builtin_amdgcn_mbcnt_lo(~0u, 0u)), tid = wid * 64 + lane, wr = wid >> 2, wc = wid & 3, fr = lane & 15, fq = lane >> 4;
    const int K = g.K, nt = K / BK;
    unsigned voffA[2], voffB[2];
#pragma unroll
    for (int i = 0; i < 2; ++i) { int R, C; stage_rc(tid * 16 + i * 8192, R, C); const int Rb = Epi::PERM ? ((R & ~31) + perm32(R & 31)) : R;
        voffA[i] = (unsigned)(R * g.lda + C) * 2u; voffB[i] = (unsigned)(Rb * g.ldb + C) * 2u; }
    const size_t kstep = (size_t)(BK * 2);
    const size_t hstepA = (size_t)HALF * g.lda * 2, hstepB = (size_t)HALF * g.ldb * 2;
    const size_t tstepA = 2 * hstepA, tstepB = 2 * hstepB;
    const unsigned ldsw = (unsigned)wid * 1024u;
    const int aoff = lds_byte(wr * 64 + fr, fq * 8), boff = lds_byte(wc * 32 + fr, fq * 8);
#define PG8_SA(b, h) (((b) * 2 + (h)) * HTB)
#define PG8_SB(b, h) ((4 + (b) * 2 + (h)) * HTB)
#define PG8_STAGE(bufoff, gbase, voff) do { _Pragma("unroll") for (int _i = 0; _i < 2; ++_i) \
        __builtin_amdgcn_global_load_lds((const unsigned*)((const char*)(gbase) + (voff)[_i]), (PG8_LAS unsigned*)(lds + (bufoff) + ldsw + _i * 8192), 16, 0, 0); } while (0)
#define PG8_LDA(dst, b, h) do { _Pragma("unroll") for (int m = 0; m < 4; ++m) _Pragma("unroll") for (int k = 0; k < 2; ++k) dst[m][k] = *(const PG8_LAS bf16x8*)(lds + PG8_SA(b, h) + aoff + m * 2048 + k * 1024); } while (0)
#define PG8_LDB(dst, b, h) do { _Pragma("unroll") for (int n = 0; n < 2; ++n) _Pragma("unroll") for (int k = 0; k < 2; ++k) dst[n][k] = *(const PG8_LAS bf16x8*)(lds + PG8_SB(b, h) + boff + n * 2048 + k * 1024); } while (0)
#define PG8_MMA(ai, bj, At, Bt) do { __builtin_amdgcn_s_setprio(1); _Pragma("unroll") for (int m = 0; m < 4; ++m) _Pragma("unroll") for (int n = 0; n < 2; ++n) _Pragma("unroll") for (int k = 0; k < 2; ++k) \
        acc[ai][bj][m][n] = __builtin_amdgcn_mfma_f32_16x16x32_bf16(Bt[n][k], At[m][k], acc[ai][bj][m][n], 0, 0, 0); __builtin_amdgcn_s_setprio(0); } while (0)
#define PG8_WAIT_V(n) asm volatile("s_waitcnt vmcnt(" #n ")" ::: "memory")
#define PG8_WAIT_L(n) asm volatile("s_waitcnt lgkmcnt(" #n ")" ::: "memory")
#define PG8_BAR __builtin_amdgcn_s_barrier()
#define PG8_SCHED __builtin_amdgcn_sched_barrier(0)
    Unit cur, nxt; int ui = 0;
    if (!S.next(0, cur)) return;
    f32x4 acc[2][2][4][2];
#pragma unroll
    for (int a = 0; a < 2; ++a)
#pragma unroll
        for (int b = 0; b < 2; ++b)
#pragma unroll
            for (int m = 0; m < 4; ++m)
#pragma unroll
                for (int n = 0; n < 2; ++n) acc[a][b][m][n] = (f32x4){0.f, 0.f, 0.f, 0.f};
    bf16x8 At[4][2], B0[2][2], B1[2][2];
    const char* cA = (const char*)g.A + (size_t)cur.pm * tstepA; const char* cB = (const char*)g.Bt + (size_t)cur.pn * tstepB;
    S.a_ready(cur);
    if constexpr (SP2) {
        PG8_STAGE(PG8_SB(0, 0), cB, voffB); PG8_STAGE(PG8_SB(0, 1), cB + hstepB, voffB); PG8_STAGE(PG8_SA(0, 0), cA, voffA); PG8_STAGE(PG8_SA(0, 1), cA + hstepA, voffA);
        if (wr == 1) PG8_BAR;
        PG8_WAIT_V(2); PG8_BAR;
        PG8_STAGE(PG8_SB(1, 0), cB + kstep, voffB); PG8_STAGE(PG8_SA(1, 0), cA + kstep, voffA); PG8_STAGE(PG8_SB(1, 1), cB + hstepB + kstep, voffB);
        PG8_WAIT_V(6); PG8_BAR;
    } else {
        PG8_STAGE(PG8_SB(0, 0), cB, voffB); PG8_STAGE(PG8_SA(0, 0), cA, voffA); PG8_STAGE(PG8_SB(0, 1), cB + hstepB, voffB); PG8_STAGE(PG8_SA(0, 1), cA + hstepA, voffA);
        if (wr == 1) PG8_BAR;
        PG8_WAIT_V(4); PG8_BAR;
        PG8_STAGE(PG8_SB(1, 0), cB + kstep, voffB); PG8_STAGE(PG8_SA(1, 0), cA + kstep, voffA); PG8_STAGE(PG8_SB(1, 1), cB + hstepB + kstep, voffB);
        PG8_WAIT_V(6); PG8_BAR;
    }
    for (;;) {
        const bool has_next = S.next(ui + 1, nxt);
        const char* nA = has_next ? (const char*)g.A + (size_t)nxt.pm * tstepA : cA; const char* nB = has_next ? (const char*)g.Bt + (size_t)nxt.pn * tstepB : cB;
        for (int t = 0; t < nt; t += 2) {
            const bool last = (t == nt - 2);
            const char* a1 = cA + (size_t)(t + 1) * kstep;
            const char* a2 = last ? nA : cA + (size_t)(t + 2) * kstep; const char* b2 = last ? nB : cB + (size_t)(t + 2) * kstep;
            const char* a3 = a2 + kstep; const char* b3 = b2 + kstep;
            if (last && has_next) S.a_ready(nxt);
            if constexpr (SP2) {
            PG8_LDB(B0, 0, 0); PG8_LDB(B1, 0, 1); PG8_SCHED; PG8_LDA(At, 0, 0); PG8_STAGE(PG8_SA(1, 1), a1 + hstepA, voffA);
            PG8_WAIT_V(8); PG8_WAIT_L(0); PG8_BAR; PG8_MMA(0, 0, At, B0); PG8_MMA(0, 1, At, B1); PG8_BAR; PG8_SCHED;
            PG8_LDA(At, 0, 1); PG8_STAGE(PG8_SB(0, 0), b2, voffB); PG8_STAGE(PG8_SB(0, 1), b2 + hstepB, voffB); PG8_STAGE(PG8_SA(0, 0), a2, voffA);
            PG8_WAIT_V(8); PG8_WAIT_L(0); PG8_BAR; PG8_MMA(1, 0, At, B0); PG8_MMA(1, 1, At, B1); PG8_BAR; PG8_SCHED;
            PG8_LDB(B0, 1, 0); PG8_LDB(B1, 1, 1); PG8_SCHED; PG8_LDA(At, 1, 0); PG8_STAGE(PG8_SA(0, 1), a2 + hstepA, voffA);
            PG8_WAIT_V(8); PG8_WAIT_L(0); PG8_BAR; PG8_MMA(0, 0, At, B0); PG8_MMA(0, 1, At, B1); PG8_BAR; PG8_SCHED;
            PG8_LDA(At, 1, 1); PG8_STAGE(PG8_SB(1, 0), b3, voffB); PG8_STAGE(PG8_SB(1, 1), b3 + hstepB, voffB); PG8_STAGE(PG8_SA(1, 0), a3, voffA);
            PG8_WAIT_V(8); PG8_WAIT_L(0); PG8_BAR; PG8_MMA(1, 0, At, B0); PG8_MMA(1, 1, At, B1); PG8_BAR; PG8_SCHED;
            } else {
            PG8_LDB(B0, 0, 0); PG8_SCHED; PG8_LDA(At, 0, 0); PG8_STAGE(PG8_SA(1, 1), a1 + hstepA, voffA);
            PG8_WAIT_L(8); PG8_BAR; PG8_WAIT_L(0); PG8_MMA(0, 0, At, B0); PG8_BAR; PG8_SCHED;
            PG8_LDB(B1, 0, 1); PG8_STAGE(PG8_SB(0, 0), b2, voffB);
            PG8_BAR; PG8_WAIT_L(0); PG8_MMA(0, 1, At, B1); PG8_BAR;
            PG8_LDA(At, 0, 1); PG8_STAGE(PG8_SA(0, 0), a2, voffA);
            PG8_BAR; PG8_WAIT_L(0); PG8_MMA(1, 0, At, B0); PG8_BAR; PG8_SCHED;
            PG8_STAGE(PG8_SB(0, 1), b2 + hstepB, voffB);
            PG8_WAIT_V(6); PG8_BAR; PG8_MMA(1, 1, At, B1); PG8_BAR;
            PG8_LDB(B0, 1, 0); PG8_SCHED; PG8_LDA(At, 1, 0); PG8_STAGE(PG8_SA(0, 1), a2 + hstepA, voffA);
            PG8_WAIT_L(8); PG8_BAR; PG8_WAIT_L(0); PG8_MMA(0, 0, At, B0); PG8_BAR; PG8_SCHED;
            PG8_LDB(B1, 1, 1); PG8_STAGE(PG8_SB(1, 0), b3, voffB);
            PG8_BAR; PG8_WAIT_L(0); PG8_MMA(0, 1, At, B1); PG8_BAR;
            PG8_LDA(At, 1, 1); PG8_STAGE(PG8_SA(1, 0), a3, voffA);
            PG8_BAR; PG8_WAIT_L(0); PG8_MMA(1, 0, At, B0); PG8_BAR; PG8_SCHED;
            PG8_STAGE(PG8_SB(1, 1), b3 + hstepB, voffB);
            PG8_WAIT_V(6); PG8_BAR; PG8_MMA(1, 1, At, B1); PG8_BAR;
            }
        }
        if constexpr (ALIGN_EPI) { if (wr == 0) PG8_BAR; }
        if constexpr (!Epi::AFTER_DRAIN) { E(acc, cur, wr, wc, fr, fq); S.done(cur); }
        if (!has_next) break;
#pragma unroll
        for (int a = 0; a < 2; ++a)
#pragma unroll
            for (int b = 0; b < 2; ++b)
#pragma unroll
                for (int m = 0; m < 4; ++m)
#pragma unroll
                    for (int n = 0; n < 2; ++n) acc[a][b][m][n] = (f32x4){0.f, 0.f, 0.f, 0.f};
        cur = nxt; cA = nA; cB = nB; ++ui;
        if constexpr (ALIGN_EPI) { if (wr == 1) PG8_BAR; }
    }
    PG8_WAIT_V(0);
    if constexpr (!ALIGN_EPI) { if (wr == 0) PG8_BAR; }
    PG8_BAR;
    if constexpr (Epi::AFTER_DRAIN) { E.fused(acc, cur, wr, wc, fr, fq, lds, wid, lane); S.done(cur); }
#undef PG8_SA
#undef PG8_SB
#undef PG8_STAGE
#undef PG8_LDA
#undef PG8_LDB
#undef PG8_MMA
#undef PG8_WAIT_V
#undef PG8_WAIT_L
#undef PG8_BAR
#undef PG8_SCHED
}
}
#define GAS __attribute__((address_space(1)))
#define LAS __attribute__((address_space(3)))
typedef unsigned short bf16;
typedef unsigned v4u __attribute__((ext_vector_type(4)));
typedef float f32x4 __attribute__((ext_vector_type(4)));
typedef short bf16x8 __attribute__((ext_vector_type(8)));
typedef GAS unsigned gu32;
typedef GAS unsigned long long gu64;
#define RLX_AGENT __ATOMIC_RELAXED, __HIP_MEMORY_SCOPE_AGENT
#define LDS_WAIT() asm volatile("s_waitcnt lgkmcnt(0)" ::: "memory")
#define VM_WAIT() asm volatile("s_waitcnt vmcnt(0)" ::: "memory")
__device__ __forceinline__ unsigned long long rt() { return __builtin_amdgcn_s_memrealtime(); }
__device__ __forceinline__ unsigned f2bf(float f) { unsigned u = __builtin_bit_cast(unsigned, f); return (u + 0x7fffu + ((u >> 16) & 1u)) >> 16; }
__device__ __forceinline__ unsigned pk2(float lo, float hi) { return f2bf(lo) | (f2bf(hi) << 16); }

#define XB_TMO      128
#define XB_XCNT(j)  (256  + 64 * (j))
#define XB_XSUB(j)  (1280 + 64 * (j))
#define XB_XGEN(j)  (2304 + 64 * (j))
#define XB_TOP      3328
#define XB_TOPGEN   3392
#define XCD_BAR_WORDS 3456
#define XB_SPIN_CAP (1u << 18)

__device__ __forceinline__ unsigned xb_ld(unsigned* p)              { return __hip_atomic_load(p, __ATOMIC_RELAXED, __HIP_MEMORY_SCOPE_AGENT); }
__device__ __forceinline__ unsigned xb_add(unsigned* p, unsigned v) { return __hip_atomic_fetch_add(p, v, __ATOMIC_RELAXED, __HIP_MEMORY_SCOPE_AGENT); }
__device__ __forceinline__ unsigned xb_xcc_id() { return (unsigned)__builtin_amdgcn_s_getreg((3 << 11) | 20) & 0xFu; }
#define XB_SPIN(cond, bar) do { unsigned _sp = 0; while (cond) { __builtin_amdgcn_s_sleep(1); \
    if ((++_sp & 255u) == 0u) { if (xb_ld(&(bar)[XB_TMO])) break; if (_sp > XB_SPIN_CAP) { atomicAdd(&(bar)[XB_TMO], 1u); break; } } } } while (0)

struct XcdBarrier {
    unsigned* bar; unsigned x;
    volatile LAS unsigned* st;
};

__device__ __forceinline__ XcdBarrier xcd_barrier_post(unsigned* bar, volatile LAS unsigned* st) {
    XcdBarrier b; b.bar = bar; b.x = xb_xcc_id(); b.st = st;
    if (threadIdx.x == 0) (void)xb_add(&bar[XB_XCNT(b.x)], 1u);
    return b;
}
__device__ __forceinline__ void xcd_barrier_complete(unsigned* bar, unsigned x, unsigned& nloc, unsigned& nx) {
    const unsigned G = gridDim.x * gridDim.y * gridDim.z;
    unsigned sum, cnt, mine, sp = 0u;
    for (;;) {
        sum = 0u; cnt = 0u; mine = 0u;
#pragma unroll
        for (unsigned j = 0; j < 16; ++j) { const unsigned c = xb_ld(&bar[XB_XCNT(j)]); sum += c; cnt += (c > 0u) ? 1u : 0u; mine = (j == x) ? c : mine; }
        if (sum == G) break;
        __builtin_amdgcn_s_sleep(1);
        if ((++sp & 255u) == 0u) { if (xb_ld(&bar[XB_TMO])) break; if (sp > XB_SPIN_CAP) { atomicAdd(&bar[XB_TMO], 1u); break; } }
    }
    nloc = mine > 0u ? mine : 1u; nx = cnt > 0u ? cnt : 1u;
}

__device__ __forceinline__ int lane_id_() { return (int)__builtin_amdgcn_mbcnt_hi(~0u, __builtin_amdgcn_mbcnt_lo(~0u, 0u)); }
__device__ __forceinline__ void xcd_barrier(const XcdBarrier& b, int wave_) {
    asm volatile("s_waitcnt vmcnt(0)" ::: "memory");
    __syncthreads();
    if (wave_ == 0 && lane_id_() == 0) {
        unsigned* bar = b.bar;
        __builtin_amdgcn_s_waitcnt(0);
        unsigned nloc = b.st[0], nx = b.st[1];
        if (nloc == 0u) { xcd_barrier_complete(bar, b.x, nloc, nx); b.st[0] = nloc; b.st[1] = nx; }
        const unsigned old = xb_add(&bar[XB_XSUB(b.x)], 1u);
        const unsigned gen = old / nloc;
        if (old + 1u == (gen + 1u) * nloc) {
            __builtin_amdgcn_fence(__ATOMIC_RELEASE, "agent");
            asm volatile("s_waitcnt vmcnt(0)" ::: "memory");
            const unsigned og = xb_add(&bar[XB_TOP], 1u);
            const unsigned tg = og / nx;
            if (og + 1u == (tg + 1u) * nx) xb_add(&bar[XB_TOPGEN], 1u);
            else XB_SPIN(xb_ld(&bar[XB_TOPGEN]) == tg, bar);
            __builtin_amdgcn_fence(__ATOMIC_ACQUIRE, "agent");
            xb_add(&bar[XB_XGEN(b.x)], 1u);
            asm volatile("s_waitcnt vmcnt(0)" ::: "memory");
        } else {
            XB_SPIN(xb_ld(&bar[XB_XGEN(b.x)]) == gen, bar);
            __builtin_amdgcn_fence(__ATOMIC_ACQUIRE, "agent");
            asm volatile("s_waitcnt vmcnt(0)" ::: "memory");
        }
    }
    __syncthreads();
}
constexpr int NWAVES = 8;
constexpr int B_ = 2, T_ = 4096, D_ = 2048, M_ = B_ * T_;
constexpr int NKV = 2, HD = 128, NCMP = 255, NSEL = 64, TOPK = 16, WIN = 512;
constexpr int DFF = 8192, INW = 5656, NQT = 5888;
constexpr float EPS = 1e-6f, NEGV = -1e30f, FORCEV = 1e9f;
constexpr float LOG2E = 1.4426950408889634f;
constexpr float QSCALE = 0.08838834764831845f * 1.4426950408889634f;

constexpr size_t MiB = 1u << 20;
constexpr size_t WS_CTL = 0, CTL_ZERO_BYTES = 131072;
constexpr size_t WS_PEB = 1 * MiB;
constexpr size_t WS_SELM = 1 * MiB + 128 * 1024;
constexpr size_t WS_KCMP = 1 * MiB + 256 * 1024;
constexpr size_t WS_VCMP = 1 * MiB + 512 * 1024;
constexpr size_t WS_GATES = 2 * MiB;
constexpr size_t WS_WDN = 4 * MiB, WS_WUP = 36 * MiB;
constexpr size_t WS_H = 68 * MiB;
constexpr size_t WS_F = 36 * MiB;
constexpr size_t WS_U = 100 * MiB;
constexpr size_t WS_WIN = 100 * MiB;
constexpr size_t WS_SLAB = 100 * MiB;
constexpr size_t WS_WO = 124 * MiB;
constexpr size_t WS_W1 = 132 * MiB;
constexpr size_t WS_Q = 136 * MiB;
constexpr size_t WS_KV = 152 * MiB;
constexpr size_t WS_C3 = 176 * MiB;
constexpr size_t WS_OC = 228 * MiB, WS_OW = 244 * MiB;
constexpr size_t WS_END = 260 * MiB;
constexpr size_t KVSZ = (size_t)4 * 4096 * 128;

constexpr int RING_BYTES = 135168;
constexpr int LDSCTL_OFF = RING_BYTES, MISC_OFF = LDSCTL_OFF + 320;
constexpr int LDS_BYTES = RING_BYTES + 1024;

__device__ __constant__ unsigned char BUCKET_TAB[128] = {
  0, 1, 2, 3, 4, 5, 6, 7, 8, 9, 10, 11, 12, 13, 14, 15, 16, 16, 16, 17, 17, 18, 18, 18, 19, 19, 19, 20, 20, 20, 20, 21, 21, 21, 21, 22, 22, 22, 22, 22,
  23, 23, 23, 23, 23, 23, 24, 24, 24, 24, 24, 24, 25, 25, 25, 25, 25, 25, 25, 26, 26, 26, 26, 26, 26, 26, 26, 27, 27, 27, 27, 27, 27, 27, 27, 27, 27,
  28, 28, 28, 28, 28, 28, 28, 28, 28, 28, 29, 29, 29, 29, 29, 29, 29, 29, 29, 29, 29, 29, 30, 30, 30, 30, 30, 30, 30, 30, 30, 30, 30, 30, 30, 30,
  31, 31, 31, 31, 31, 31, 31, 31, 31, 31, 31, 31, 31, 31, 31};
__device__ __forceinline__ int rel_bucket(int dist) { int n = dist < 0 ? 0 : dist; return n >= 113 ? 31 : (int)BUCKET_TAB[n]; }
__device__ __forceinline__ int rel_bucket_arith(int n) {
    int r = 16 + (n >= 19) + (n >= 21) + (n >= 24) + (n >= 27) + (n >= 31) + (n >= 35) + (n >= 40) + (n >= 46) + (n >= 52) + (n >= 59) + (n >= 67) + (n >= 77) + (n >= 87) + (n >= 99) + (n >= 113);
    return n < 16 ? n : r;
}
__device__ __forceinline__ float bf2f(unsigned short v) { return __builtin_bit_cast(float, (unsigned)v << 16); }

__device__ __forceinline__ float wave_sum(float v) {
#pragma unroll
    for (int o = 1; o < 64; o <<= 1) v += __shfl_xor(v, o);
    return v;
}

__device__ __forceinline__ int win_src_col(int n) { return n < 2560 ? n : (n < 5632 ? n + 24 : (n < 5656 ? n - 5632 + 2560 : -1)); }
__device__ __forceinline__ void p0_transpose_item(const float* W, int ldw, int K, int nblk, bf16* WT, LAS float* scr, int item, int lane, bool remap) {
    const int kb = item / nblk, nb = item % nblk, k0 = 64 * kb, n0 = 64 * nb;
    const int c4 = (lane & 15) * 4, kr = lane >> 4;
    const int nn = n0 + c4; const int sc = remap ? win_src_col(nn) : nn;
    f32x4 v[16];
#pragma unroll
    for (int i = 0; i < 16; ++i) v[i] = sc >= 0 ? *(const GAS f32x4*)(W + (size_t)(k0 + kr + 4 * i) * ldw + sc) : (f32x4){0.f, 0.f, 0.f, 0.f};
#pragma unroll
    for (int i = 0; i < 16; ++i) { LAS float* d = scr + (kr + 4 * i) * 65 + c4; d[0] = v[i].x; d[1] = v[i].y; d[2] = v[i].z; d[3] = v[i].w; }
    LDS_WAIT(); asm volatile("" ::: "memory");
    const int c = lane & 7;
#pragma unroll
    for (int j = 0; j < 8; ++j) { const int n = (lane >> 3) + 8 * j; const LAS float* sp = scr + (8 * c) * 65 + n;
        v4u o; o.x = pk2(sp[0 * 65], sp[1 * 65]); o.y = pk2(sp[2 * 65], sp[3 * 65]); o.z = pk2(sp[4 * 65], sp[5 * 65]); o.w = pk2(sp[6 * 65], sp[7 * 65]);
        *(GAS v4u*)(WT + (size_t)(n0 + n) * K + k0 + 8 * c) = o; }
    LDS_WAIT(); asm volatile("" ::: "memory");
}
__device__ __forceinline__ void rms_row_to_bf16(const float* xrow, const float* gain, bf16* orow, int lane) {
    const GAS f32x4* xr = (const GAS f32x4*)xrow + lane; const GAS f32x4* gr = (const GAS f32x4*)gain + lane;
    f32x4 v[8]; float s = 0.f;
#pragma unroll
    for (int j = 0; j < 8; ++j) { v[j] = xr[64 * j]; s += (v[j].x * v[j].x + v[j].y * v[j].y) + (v[j].z * v[j].z + v[j].w * v[j].w); }
    const float r = rsqrtf(wave_sum(s) * (1.f / D_) + EPS);
    GAS unsigned long long* o8 = (GAS unsigned long long*)orow + lane;
#pragma unroll
    for (int j = 0; j < 8; ++j) { const f32x4 g = gr[64 * j];
        o8[64 * j] = (unsigned long long)pk2((v[j].x * r) * g.x, (v[j].y * r) * g.y) | ((unsigned long long)pk2((v[j].z * r) * g.z, (v[j].w * r) * g.w) << 32); }
}

namespace att {
typedef short bf16x8 __attribute__((ext_vector_type(8)));
typedef short s16x4 __attribute__((ext_vector_type(4)));
typedef float f32x16 __attribute__((ext_vector_type(16)));
typedef float f32x2_t __attribute__((ext_vector_type(2)));
typedef __bf16 bf16x2_t __attribute__((ext_vector_type(2)));
typedef short v4i16_t __attribute__((ext_vector_type(4)));
typedef LAS const char* lcp;
__device__ __forceinline__ unsigned cvtpk(float lo, float hi) { f32x2_t v = {lo, hi}; bf16x2_t b = __builtin_convertvector(v, bf16x2_t); return __builtin_bit_cast(unsigned, b); }
__device__ __forceinline__ s16x4 vtr(lcp p) { return __builtin_bit_cast(s16x4, __builtin_amdgcn_ds_read_tr16_b64_v4i16((LAS v4i16_t*)p)); }

constexpr int STAGE_B = 32768, BIAS_OFF = 133120, IMP_OFF = 65536, IMP_FLOATS = 2 * 4 * 64 * 33;
constexpr float MINIT = -1e29f, MASKED = -1e30f;

__device__ __forceinline__ void tile_issue(LAS unsigned char* lds, int stage, const char* kt, const char* vt, const unsigned (&koff)[2], const unsigned (&voff)[2], int wave) {
#pragma unroll
    for (int i = 0; i < 2; ++i) {
        __builtin_amdgcn_global_load_lds((const unsigned*)(kt + koff[i]), (LAS unsigned*)(lds + stage * STAGE_B + (wave * 2 + i) * 1024), 16, 0, 0);
        __builtin_amdgcn_global_load_lds((const unsigned*)(vt + voff[i]), (LAS unsigned*)(lds + stage * STAGE_B + 16384 + (wave * 2 + i) * 1024), 16, 0, 0);
    }
}
__device__ __forceinline__ void qk_tile(f32x16& p0, f32x16& p1, lcp kb, const bf16x8 (&qf)[8], int lane, float init) {
    const int r = lane & 31, h2 = lane >> 5;
#pragma unroll
    for (int e = 0; e < 16; ++e) { p0[e] = init; p1[e] = init; }
    lcp k0 = kb + r * 256, k1 = kb + (r + 32) * 256;
#pragma unroll
    for (int s = 0; s < 8; ++s) { const int off = ((2 * s + h2) ^ (r & 15)) << 4;
        const bf16x8 a0 = *(const LAS bf16x8*)(k0 + off), a1 = *(const LAS bf16x8*)(k1 + off);
        p0 = __builtin_amdgcn_mfma_f32_32x32x16_bf16(a0, qf[s], p0, 0, 0, 0);
        p1 = __builtin_amdgcn_mfma_f32_32x32x16_bf16(a1, qf[s], p1, 0, 0, 0); }
}
__device__ __forceinline__ void pv_addrs(unsigned (&va1)[4], unsigned (&va2)[4], int lane) {
    const int i16 = lane & 15, q4 = i16 >> 2, p4 = i16 & 3, gl = (lane >> 4) & 1, h2 = lane >> 5, cl = 2 * gl + (p4 >> 1);
#pragma unroll
    for (int db = 0; db < 4; ++db) {
        va1[db] = (unsigned)((4 * h2 + q4) * 256 + (((((db ^ q4) << 2) | (cl ^ h2))) << 4) + 8 * (p4 & 1));
        va2[db] = (unsigned)((4 * h2 + q4 + 8) * 256 + (((((db ^ q4) << 2) | (cl ^ (h2 + 2)))) << 4) + 8 * (p4 & 1));
    }
}
__device__ __forceinline__ void pv_tile(f32x16 (&o)[4], lcp vb, const bf16x8 (&pf)[4], const unsigned (&va1)[4], const unsigned (&va2)[4]) {
#pragma unroll
    for (int s = 0; s < 4; ++s) { const int boff = (32 * (s >> 1) + 16 * (s & 1)) * 256;
#pragma unroll
        for (int db = 0; db < 4; ++db) {
            const s16x4 lo = vtr(vb + va1[db] + boff), hi = vtr(vb + va2[db] + boff);
            bf16x8 a; a[0] = lo[0]; a[1] = lo[1]; a[2] = lo[2]; a[3] = lo[3]; a[4] = hi[0]; a[5] = hi[1]; a[6] = hi[2]; a[7] = hi[3];
            o[db] = __builtin_amdgcn_mfma_f32_32x32x16_bf16(a, pf[s], o[db], 0, 0, 0); } }
}
#define ATT_OFF(r) (((r) & 3) + 8 * ((r) >> 2))
#ifdef STAMP_MODE
#define ASTAMP(k) do { if (MODE == STAMP_MODE && P.stamps && tid == 0) P.stamps[k] = __builtin_amdgcn_s_memrealtime(); } while (0)
#else
#define ASTAMP(k) do {} while (0)
#endif
#define LADD(p, v) (void)__hip_atomic_fetch_add((p), (v), __ATOMIC_RELAXED, __HIP_MEMORY_SCOPE_WORKGROUP)

struct AttnBufs { const bf16* Q; const bf16* K; const bf16* V; int kvrows;
                  const float* rel_bias; const unsigned long long* selm_in; unsigned long long* selm_out; const float* gates;
                  bf16* OC; bf16* OW; bf16* AO; unsigned long long* stamps; };

template <int MODE>
__device__ __forceinline__ void attn_item(LAS unsigned char* lds, const AttnBufs& P, int b, int g, int qA0, int qB0, int tid, int lane, int wave) {
    asm volatile("" : "+v"(lane), "+v"(tid));
    const int half = wave >> 2, hh = wave & 3, head = g * 4 + hh, bg = b * NKV + g;
    const int q0 = half ? qB0 : qA0, ql = lane & 31, hi = lane >> 5, t = q0 + ql;
    const size_t row = (size_t)b * T_ + t;
    int jlo_w, jhi_w, jlo_g, jhi_g;
    if (MODE == 0) { jlo_w = 0; jhi_w = (q0 + 31) >> 6; jlo_g = 0; const int qm = qA0 > qB0 ? qA0 : qB0; jhi_g = (qm + 31) >> 6; }
    else if (MODE == 1) { const int lo_ = q0 - (WIN - 1); jlo_w = lo_ < 0 ? 0 : (lo_ >> 6); jhi_w = (q0 + 31) >> 6;
                          const int qn = qA0 < qB0 ? qA0 : qB0, qm = qA0 > qB0 ? qA0 : qB0; const int lg = qn - (WIN - 1); jlo_g = lg < 0 ? 0 : (lg >> 6); jhi_g = (qm + 31) >> 6; }
    else { jlo_w = 0; jhi_w = q0 >> 10; jlo_g = 0; const int qm = qA0 > qB0 ? qA0 : qB0; jhi_g = qm >> 10; }
    const bf16* Kg = P.K + (size_t)bg * P.kvrows * HD; const bf16* Vg = P.V + (size_t)bg * P.kvrows * HD;
    { const int h_ = tid >> 7, idx = tid & 127; ((LAS float*)(lds + BIAS_OFF))[tid] = idx <= 113 ? P.rel_bias[(g * 4 + h_) * 32 + rel_bucket_arith(idx)] * LOG2E : 0.f; }
    if (MODE == 2) { for (int i = tid; i < IMP_FLOATS; i += 512) ((LAS float*)(lds + IMP_OFF))[i] = 0.f; }
    bf16x8 qf[8];
    { const bf16* qp = P.Q + row * 1024 + head * HD + 8 * hi;
#pragma unroll
      for (int s = 0; s < 8; ++s) qf[s] = *(const GAS bf16x8*)(qp + 16 * s); }
    unsigned long long selm = 0ull;
    if (MODE == 0) selm = P.selm_in[(size_t)bg * T_ + t];
    const LAS float* bt = (const LAS float*)(lds + BIAS_OFF) + hh * 128;
    float b31 = P.rel_bias[(g * 4 + hh) * 32 + 31] * LOG2E;
    asm volatile("s_waitcnt vmcnt(0)" : "+v"(qf[0]), "+v"(qf[1]), "+v"(qf[2]), "+v"(qf[3]), "+v"(qf[4]), "+v"(qf[5]), "+v"(qf[6]), "+v"(qf[7]), "+v"(selm), "+v"(b31) :: "memory");
    unsigned koff[2], voff[2];
#pragma unroll
    for (int i = 0; i < 2; ++i) { const int rw = (wave * 2 + i) * 4 + (lane >> 4), c_ = lane & 15;
        koff[i] = (unsigned)(rw * 256 + ((c_ ^ (rw & 15)) << 4)); voff[i] = (unsigned)(rw * 256 + ((c_ ^ (((rw & 3) << 2) | ((rw >> 2) & 3))) << 4)); }
    constexpr int NST = (MODE == 2) ? 2 : 4;
    unsigned va1[4], va2[4]; pv_addrs(va1, va2, lane);
    f32x16 o[4];
#pragma unroll
    for (int d = 0; d < 4; ++d)
#pragma unroll
        for (int e = 0; e < 16; ++e) o[d][e] = 0.f;
    float m = MINIT, l = 0.f, invl = 0.f, icarry = 0.f;
    const int cmax = (MODE == 2) ? (((t - 31) >> 4) < 254 ? ((t - 31) >> 4) : 254) : 0;

    ASTAMP(1);
    constexpr int NPASS = (MODE == 2) ? 2 : 1;
#pragma unroll 1
    for (int pass = 0; pass < NPASS; ++pass) {
        icarry = 0.f;
        const char* kbase = (const char*)Kg; const char* vbase = (const char*)Vg;
#pragma unroll
        for (int pj = 0; pj < NST - 1; ++pj) if (jlo_g + pj <= jhi_g) tile_issue(lds, pj, kbase + (size_t)(jlo_g + pj) * 16384, vbase + (size_t)(jlo_g + pj) * 16384, koff, voff, wave);
#pragma unroll 1
        for (int j = jlo_g; j <= jhi_g; ++j) {
            const int st = (j - jlo_g) % NST;
            const int ahead = jhi_g - j;
            if (NST == 4 && ahead >= 2) asm volatile("s_waitcnt vmcnt(8)" ::: "memory");
            else if (NST == 4 && ahead == 1) asm volatile("s_waitcnt vmcnt(4)" ::: "memory");
            else asm volatile("s_waitcnt vmcnt(0)" ::: "memory");
            __builtin_amdgcn_s_barrier();
            if (j + NST - 1 <= jhi_g) tile_issue(lds, (j - jlo_g + NST - 1) % NST, kbase + (size_t)(j + NST - 1) * 16384, vbase + (size_t)(j + NST - 1) * 16384, koff, voff, wave);
            const int cur = st;
            if (j >= jlo_w && j <= jhi_w) {
                f32x16 p0, p1;
                const bool far = (MODE == 0) ? (64 * j + 63 + 113 <= q0) : (MODE == 1) ? (64 * j + 63 + 113 <= q0 && (q0 + 31) - 64 * j < WIN) : false;
                qk_tile(p0, p1, (lcp)(lds + cur * STAGE_B), qf, lane, far ? b31 : 0.f);
                float mx = MASKED;
                bool lane_on = true;
                if (MODE != 2 && far) {
                    float a_ = fmaxf(p0[0], p1[0]), b_ = fmaxf(p0[1], p1[1]);
#pragma unroll
                    for (int r = 2; r < 16; r += 2) { a_ = fmaxf(a_, fmaxf(p0[r], p1[r])); b_ = fmaxf(b_, fmaxf(p0[r + 1], p1[r + 1])); }
                    mx = fmaxf(a_, b_);
                    if (MODE == 0) { lane_on = ((selm >> j) & 1ull) != 0ull; mx = lane_on ? mx : MASKED; }
                } else if (MODE == 2) {
                    const int c0 = 64 * j + 4 * hi, dd0 = t - 31 - 16 * c0;
#pragma unroll
                    for (int r = 0; r < 16; ++r) {
                        { const int c = c0 + ATT_OFF(r), dist = dd0 - 16 * ATT_OFF(r); const int idx = dist < 0 ? 0 : (dist > 113 ? 113 : dist);
                          float s = p0[r] + bt[idx]; s = (c <= cmax) ? s : MASKED; p0[r] = s; mx = fmaxf(mx, s); }
                        { const int c = c0 + 32 + ATT_OFF(r), dist = dd0 - 512 - 16 * ATT_OFF(r); const int idx = dist < 0 ? 0 : (dist > 113 ? 113 : dist);
                          float s = p1[r] + bt[idx]; s = (c <= cmax) ? s : MASKED; p1[r] = s; mx = fmaxf(mx, s); }
                    }
                } else {
                    const int d0 = t - (64 * j + 4 * hi);
                    const bool selb = (MODE == 0) ? (((selm >> j) & 1ull) != 0ull) : true;
#pragma unroll
                    for (int r = 0; r < 16; ++r) {
                        { const int dist = d0 - ATT_OFF(r); const int idx = dist < 0 ? 0 : (dist > 113 ? 113 : dist);
                          const bool valid = (MODE == 0) ? (dist >= 0 && selb) : (dist >= 0 && dist < WIN);
                          float s = p0[r] + bt[idx]; s = valid ? s : MASKED; p0[r] = s; mx = fmaxf(mx, s); }
                        { const int dist = d0 - 32 - ATT_OFF(r); const int idx = dist < 0 ? 0 : (dist > 113 ? 113 : dist);
                          const bool valid = (MODE == 0) ? (dist >= 0 && selb) : (dist >= 0 && dist < WIN);
                          float s = p1[r] + bt[idx]; s = valid ? s : MASKED; p1[r] = s; mx = fmaxf(mx, s); }
                    }
                }
                if (MODE != 2 || pass == 0) {
                    mx = fmaxf(mx, __shfl_xor(mx, 32));
                    const float mn = fmaxf(m, mx), alpha = __builtin_amdgcn_exp2f(m - mn); m = mn;
                    const float sub = lane_on ? mn : 1e30f;
                    float ls = 0.f;
#pragma unroll
                    for (int r = 0; r < 16; ++r) { p0[r] = __builtin_amdgcn_exp2f(p0[r] - sub); p1[r] = __builtin_amdgcn_exp2f(p1[r] - sub); ls += p0[r] + p1[r]; }
                    l = l * alpha + ls;
                    if (MODE != 2) {
                        if (__any(alpha < 1.f)) {
#pragma unroll
                            for (int d = 0; d < 4; ++d)
#pragma unroll
                                for (int e = 0; e < 16; ++e) o[d][e] *= alpha;
                        }
                    }
                } else {
#pragma unroll
                    for (int r = 0; r < 16; ++r) { p0[r] = __builtin_amdgcn_exp2f(p0[r] - m) * invl; p1[r] = __builtin_amdgcn_exp2f(p1[r] - m) * invl; }
                    LAS float* imp = (LAS float*)(lds + IMP_OFF) + (size_t)((half * 4 + hh) * 64) * 33 + ql;
                    float o0[4], o1[4];
#pragma unroll
                    for (int k = 0; k < 4; ++k) { o0[k] = __shfl_xor(p0[4 * k + 3], 32); o1[k] = __shfl_xor(p1[4 * k + 3], 32); }
#pragma unroll
                    for (int k = 0; k < 4; ++k) {
                        const int jj0 = 16 * j + 2 * k + hi, jj1 = jj0 + 8;
                        const float G0 = (p0[4 * k] + p0[4 * k + 1]) + (p0[4 * k + 2] + p0[4 * k + 3]);
                        const float G1 = (p1[4 * k] + p1[4 * k + 1]) + (p1[4 * k + 2] + p1[4 * k + 3]);
                        const float pv0 = hi ? o0[k] : (k ? o0[k ? k - 1 : 0] : icarry);
                        const float pv1 = hi ? o1[k] : (k ? o1[k ? k - 1 : 0] : o0[3]);
                        imp[jj0 * 33] = G0 + pv0; imp[jj1 * 33] = G1 + pv1;
                    }
                    icarry = o1[3];
                }
                if (MODE != 2 || pass == 1) {
                    bf16x8 pf[4];
#pragma unroll
                    for (int s = 0; s < 4; ++s) {
                        const int rb = 8 * (s & 1);
                        unsigned w[4];
#pragma unroll
                        for (int e = 0; e < 4; ++e) w[e] = (s < 2) ? cvtpk(p0[rb + 2 * e], p0[rb + 2 * e + 1]) : cvtpk(p1[rb + 2 * e], p1[rb + 2 * e + 1]);
                        v4u wv; wv.x = w[0]; wv.y = w[1]; wv.z = w[2]; wv.w = w[3];
                        pf[s] = __builtin_bit_cast(bf16x8, wv);
                    }
                    pv_tile(o, (lcp)(lds + cur * STAGE_B + 16384), pf, va1, va2);
                }
            }
        }
        asm volatile("s_waitcnt lgkmcnt(0)" ::: "memory"); __builtin_amdgcn_s_barrier();
        if (MODE == 2 && pass == 0) { const float lt = l + __shfl_xor(l, 32); invl = lt > 0.f ? 1.f / lt : 0.f; }
        ASTAMP(2 + pass);
    }
    if (MODE != 2) { const float lt = l + __shfl_xor(l, 32); invl = 1.f / lt; }
    {
        const size_t ob = row * 1024 + head * HD + 4 * hi;
        float g0 = 0.f, g1 = 0.f, g2 = 0.f;
        if (MODE == 0) { const float* gr = P.gates + row * 24 + head * 3; g0 = gr[0]; g1 = gr[1]; g2 = gr[2]; }
#pragma unroll
        for (int db = 0; db < 4; ++db)
#pragma unroll
            for (int k = 0; k < 4; ++k) {
                float v0 = o[db][4 * k], v1 = o[db][4 * k + 1], v2 = o[db][4 * k + 2], v3 = o[db][4 * k + 3];
                if (MODE != 2) { v0 *= invl; v1 *= invl; v2 *= invl; v3 *= invl; }
                const size_t off = ob + 32 * db + 8 * k;
                if (MODE == 0) {
                    const unsigned long long c8 = *(const GAS unsigned long long*)(P.OC + off), w8 = *(const GAS unsigned long long*)(P.OW + off);
                    float r0 = g0 * bf2f((unsigned short)c8) + g1 * v0; r0 = r0 + g2 * bf2f((unsigned short)w8);
                    float r1 = g0 * bf2f((unsigned short)(c8 >> 16)) + g1 * v1; r1 = r1 + g2 * bf2f((unsigned short)(w8 >> 16));
                    float r2 = g0 * bf2f((unsigned short)(c8 >> 32)) + g1 * v2; r2 = r2 + g2 * bf2f((unsigned short)(w8 >> 32));
                    float r3 = g0 * bf2f((unsigned short)(c8 >> 48)) + g1 * v3; r3 = r3 + g2 * bf2f((unsigned short)(w8 >> 48));
                    *(GAS unsigned long long*)(P.AO + row * 2048 + head * HD + 4 * hi + 32 * db + 8 * k) = (unsigned long long)cvtpk(r0, r1) | ((unsigned long long)cvtpk(r2, r3) << 32);
                } else {
                    bf16* dst = (MODE == 1 ? P.OW : P.OC) + off;
                    *(GAS unsigned long long*)dst = (unsigned long long)cvtpk(v0, v1) | ((unsigned long long)cvtpk(v2, v3) << 32);
                }
            }
    }
    ASTAMP(4);
    if (MODE == 2) {
        __syncthreads();
        const LAS float* impb = (const LAS float*)(lds + IMP_OFF);
#pragma unroll 1
        for (int qi = 0; qi < 8; ++qi) {
            const int qidx = wave * 8 + qi, hf = qidx >> 5, q_ = qidx & 31, tt = (hf ? qB0 : qA0) + q_, cur = tt >> 6, jj = lane;
            float v = 0.f;
#pragma unroll
            for (int h_ = 0; h_ < 4; ++h_) v += impb[((hf * 4 + h_) * 64 + jj) * 33 + q_];
            if (jj == 0 || jj == cur || jj == cur - 1) v = FORCEV;
            if (jj * 64 > tt) v = NEGV;
            const unsigned uk = v < 0.f ? 0u : __float_as_uint(v) + 1u;
            unsigned long long M = ~0ull; int need = TOPK;
#pragma unroll
            for (int bit = 31; bit >= 0; --bit) {
                const unsigned long long hiM = __ballot((uk >> bit) & 1u) & M; const int c = __popcll(hiM);
                const bool ge = c >= need; M = ge ? hiM : (M & ~hiM); need = ge ? need : need - c;
            }
            const unsigned ukT = (unsigned)__builtin_amdgcn_readlane((int)uk, __builtin_ctzll(M));
            unsigned long long mk = __ballot(uk > ukT);
            for (int n_ = 0; n_ < need; ++n_) { const unsigned long long low = M & (~M + 1ull); mk |= low; M &= ~low; }
            if (lane == 0) P.selm_out[(size_t)bg * T_ + tt] = mk;
        }
    }
    ASTAMP(5);
    __syncthreads();
}
}

#ifndef REPEAT_MASK
#define REPEAT_MASK 0
#endif
struct Args { const float* in[16]; float* out; unsigned char* ws; int ph_lo, ph_hi, li, pad; };

__global__ void __launch_bounds__(NWAVES * 64, 2) mega_fwd(Args args) {
    extern __shared__ __attribute__((aligned(16))) unsigned char lds_raw[];
    LAS unsigned char* lds = (LAS unsigned char*)lds_raw;
    volatile LAS unsigned* MISC = (volatile LAS unsigned*)(lds + MISC_OFF);
    const int wave = __builtin_amdgcn_readfirstlane(threadIdx.x >> 6);
#define lane lane_id_()
#define tid (wave * 64 + lane_id_())
    const int G = gridDim.x; const int bx = blockIdx.x;
    const int vcu = (G % 8 == 0) ? (bx % 8) * (G / 8) + bx / 8 : bx;
    unsigned char* ws = args.ws;
    const float* x = args.in[0]; const float* w_in = args.in[1]; const float* pe = args.in[2];
    const float* wk1 = args.in[3]; const float* wk2 = args.in[4]; const float* wv1 = args.in[5]; const float* wv2 = args.in[6];
    const float* conv_w = args.in[7]; const float* w_o = args.in[9]; const float* w_up = args.in[10]; const float* w_down = args.in[11];
    const float* g_pre_mix = args.in[12]; const float* g_post_mix = args.in[13]; const float* g_pre_ffn = args.in[14]; const float* g_post_ffn = args.in[15];
    float* out = args.out;
    bf16* WinT = (bf16*)(ws + WS_WIN); bf16* WoT = (bf16*)(ws + WS_WO); bf16* WupT = (bf16*)(ws + WS_WUP); bf16* WdnT = (bf16*)(ws + WS_WDN);
    bf16* W1T = (bf16*)(ws + WS_W1); bf16* Hb = (bf16*)(ws + WS_H); bf16* Qb = (bf16*)(ws + WS_Q); bf16* KVb = (bf16*)(ws + WS_KV);
    bf16* C3b = (bf16*)(ws + WS_C3); bf16* Ub = (bf16*)(ws + WS_U); float* Fb = (float*)(ws + WS_F); float* SLAB = (float*)(ws + WS_SLAB);
    const float* rel_bias = args.in[8]; unsigned long long* SELM = (unsigned long long*)(ws + WS_SELM); bf16* OCb = (bf16*)(ws + WS_OC); bf16* OWb = (bf16*)(ws + WS_OW);
#ifdef STAMP_MODE
    unsigned long long* STAMPS = (vcu == STAMP_VCU) ? (unsigned long long*)(ws + WS_CTL + 110 * 1024) : nullptr;
#else
    unsigned long long* STAMPS = nullptr;
#endif
    float* PEB = (float*)(ws + WS_PEB); float* GATES = (float*)(ws + WS_GATES); bf16* KCMP = (bf16*)(ws + WS_KCMP); bf16* VCMP = (bf16*)(ws + WS_VCMP);

    for (int u = threadIdx.x; u < (LDS_BYTES - LDSCTL_OFF) / 4; u += NWAVES * 64) ((LAS unsigned*)(lds + LDSCTL_OFF))[u] = 0u;
    __syncthreads();
    XcdBarrier bar = xcd_barrier_post((unsigned*)(ws + WS_CTL) + 1024 + args.li * 4096, MISC + 8);
    const int lo = args.ph_lo, hi = args.ph_hi;
#define IN(k) (lo <= (k) && (k) < hi)
#define BOTH(k) (IN(k) && IN((k) + 1))
    const int gw = vcu * NWAVES + wave, NGW = G * NWAVES;

    if (IN(0)) for (int rep_ = 0; rep_ < (((REPEAT_MASK) >> 0) & 1) + 1; ++rep_) {
        LAS float* scr = (LAS float*)(lds + wave * 16640);
        constexpr int I_IN = 32 * (NQT / 64), I_O = 32 * 32, I_UP = 32 * 128, I_DN = 128 * 32, I_C1 = 64 * 4;
        constexpr int NITEMS = I_IN + I_O + I_UP + I_DN + 2 * I_C1;
        for (int it = gw; it < NITEMS; it += NGW) {
            int r = it;
            if (r < I_IN) { p0_transpose_item(w_in, INW, D_, NQT / 64, WinT, scr, r, lane, true); continue; } r -= I_IN;
            if (r < I_O) { p0_transpose_item(w_o, D_, 2048, 32, WoT, scr, r, lane, false); continue; } r -= I_O;
            if (r < I_UP) { p0_transpose_item(w_up, DFF, D_, 128, WupT, scr, r, lane, false); continue; } r -= I_UP;
            if (r < I_DN) { p0_transpose_item(w_down, D_, DFF, 32, WdnT, scr, r, lane, false); continue; } r -= I_DN;
            if (r < I_C1) { p0_transpose_item(wk1, 256, 4096, 4, W1T, scr, r, lane, false); continue; } r -= I_C1;
            p0_transpose_item(wv1, 256, 4096, 4, W1T + (size_t)256 * 4096, scr, r, lane, false);
        }
        for (int m = gw; m < M_; m += NGW) rms_row_to_bf16(x + (size_t)m * D_, g_pre_mix, Hb + (size_t)m * D_, lane);
        for (int it = gw; it < 256; it += NGW) {
            const int kv = it >> 7, ch = (it >> 2) & 31, hg = it & 3; const float* w1 = kv ? wv1 : wk1;
            float s = 0.f;
            for (int k = ch * 128; k < ch * 128 + 128; ++k) s += pe[k] * w1[(size_t)k * 256 + hg * 64 + lane];
            PEB[(kv * 32 + ch) * 256 + hg * 64 + lane] = s;
        }
        if (BOTH(0)) xcd_barrier(bar, wave);
    }

    if (IN(1)) for (int rep_ = 0; rep_ < (((REPEAT_MASK) >> 1) & 1) + 1; ++rep_) {
        pg8::Gemm g{Hb, WinT, M_, NQT, D_, D_, D_}; pg8::StaticOrder S; S.init(M_, NQT, G, bx);
        pg8::EpiInProj E{Qb, KVb, C3b, GATES, QSCALE};
        pg8::gemm_phase<pg8::EpiInProj, pg8::StaticOrder, true, true>(lds, g, S, E, wave);
        if (BOTH(1)) xcd_barrier(bar, wave);
    }

    if (IN(2)) for (int rep_ = 0; rep_ < (((REPEAT_MASK) >> 2) & 1) + 1; ++rep_) {
#ifdef STAMP_MODE
        if (STAMP_MODE == 1 && STAMPS && tid == 0) STAMPS[0] = __builtin_amdgcn_s_memrealtime();
#endif
        {
            const bool has = vcu < 64; const int kv = (vcu >> 5) & 1, ch = (vcu >> 2) & 7, pm = vcu & 3;
            pg8::Gemm g{KVb + (size_t)kv * KVSZ + ch * 512, W1T + (size_t)kv * 256 * 4096 + ch * 512, 1024, 256, 512, 2048, 4096};
            pg8::OneUnit S{has, {pm, 0}};
            pg8::EpiF32 E{SLAB + (size_t)(kv * 8 + ch) * 1024 * 256, 256};
            pg8::gemm_phase<pg8::EpiF32, pg8::OneUnit, false, true>(lds, g, S, E, wave);
        }
        {
            const bf16* CH = C3b; const bf16* CB = C3b + (size_t)M_ * 1024; const bf16* CC = C3b + (size_t)2 * M_ * 1024;
            const int cv0 = G > 64 ? 64 : 0, cvn = G - cv0;
            if (vcu >= cv0)
            for (int idx = (vcu - cv0) * 512 + tid; idx < M_ * 128; idx += cvn * 512) {
                const int r = idx >> 7, c8 = (idx & 127) * 8, t = r & 4095; const size_t o = (size_t)r * 1024 + c8;
                const v4u h2 = *(const GAS v4u*)(CH + o), c2 = *(const GAS v4u*)(CC + o), bb = *(const GAS v4u*)(CB + o);
                v4u h1 = {0, 0, 0, 0}, c1 = {0, 0, 0, 0}, h0 = {0, 0, 0, 0}, c0 = {0, 0, 0, 0};
                if (t >= 1) { h1 = *(const GAS v4u*)(CH + o - 1024); c1 = *(const GAS v4u*)(CC + o - 1024); }
                if (t >= 2) { h0 = *(const GAS v4u*)(CH + o - 2048); c0 = *(const GAS v4u*)(CC + o - 2048); }
                unsigned ow[4];
#pragma unroll
                for (int e = 0; e < 4; ++e) {
                    float res[2];
#pragma unroll
                    for (int p = 0; p < 2; ++p) {
                        const int sh = 16 * p; const int col = c8 + 2 * e + p;
                        const float u2 = bf2f((unsigned short)(c2[e] >> sh)) * bf2f((unsigned short)(h2[e] >> sh));
                        const float u1 = bf2f((unsigned short)(c1[e] >> sh)) * bf2f((unsigned short)(h1[e] >> sh));
                        const float u0 = bf2f((unsigned short)(c0[e] >> sh)) * bf2f((unsigned short)(h0[e] >> sh));
                        float y = conv_w[col] * u0; y = y + conv_w[1024 + col] * u1; y = y + conv_w[2048 + col] * u2;
                        res[p] = bf2f((unsigned short)(bb[e] >> sh)) * y;
                    }
                    ow[e] = pk2(res[0], res[1]);
                }
                v4u ov; ov.x = ow[0]; ov.y = ow[1]; ov.z = ow[2]; ov.w = ow[3];
                *(GAS v4u*)(Hb + (size_t)r * 2048 + 1024 + c8) = ov;
            }
        }
        {
            att::AttnBufs P{Qb, KVb + 4 * KVSZ, KVb + 5 * KVSZ, T_, rel_bias, SELM, SELM, GATES, OCb, OWb, Hb, STAMPS};
            for (int it = vcu; it < 256; it += G) { const int bg = it >> 6, qb = it & 63; att::attn_item<1>(lds, P, bg >> 1, bg & 1, 64 * qb, 64 * qb + 32, tid, lane, wave); }
        }
#ifdef STAMP_MODE
        if (STAMP_MODE == 1 && STAMPS && tid == 0) STAMPS[6] = __builtin_amdgcn_s_memrealtime();
#endif
        if (BOTH(2)) xcd_barrier(bar, wave);
#ifdef STAMP_MODE
        if (STAMP_MODE == 1 && STAMPS && tid == 0) STAMPS[7] = __builtin_amdgcn_s_memrealtime();
#endif
    }

    if (IN(3)) for (int rep_ = 0; rep_ < (((REPEAT_MASK) >> 3) & 1) + 1; ++rep_) {
        LAS float* hid = (LAS float*)lds;
        LAS f32x4* part = (LAS f32x4*)(lds + 8192);
        for (int it = vcu; it < 256; it += G) {
            const int kv = it >> 7, bg = (it >> 5) & 3, sl = it & 31, r0 = bg * 256 + sl * 8;
            const float* w2 = kv ? wv2 : wk2; bf16* outp = kv ? VCMP : KCMP;
            {
                const int h = tid & 255; float pb = 0.f;
#pragma unroll 8
                for (int c2 = 0; c2 < 32; ++c2) pb += PEB[(kv * 32 + c2) * 256 + h];
#pragma unroll
                for (int i = 0; i < 4; ++i) { const int e = tid + 512 * i, r = e >> 8; float sv[8];
#pragma unroll
                    for (int ch = 0; ch < 8; ++ch) sv[ch] = SLAB[((size_t)(kv * 8 + ch) * 1024 + r0 + r) * 256 + h];
                    float s_ = ((sv[0] + sv[1]) + (sv[2] + sv[3])) + ((sv[4] + sv[5]) + (sv[6] + sv[7])); s_ += pb; hid[e] = s_ / (1.f + __expf(-s_)); }
            }
            __syncthreads();
            {
                const int e4 = (tid & 31) * 4, r = (tid >> 5) & 7, kh = tid >> 8;
                f32x4 acc = {0.f, 0.f, 0.f, 0.f};
#pragma unroll 16
                for (int h = kh * 128; h < kh * 128 + 128; ++h) { const f32x4 w = *(const GAS f32x4*)(w2 + h * 128 + e4); const float a = hid[r * 256 + h];
                    acc.x += a * w.x; acc.y += a * w.y; acc.z += a * w.z; acc.w += a * w.w; }
                if (kh) part[tid - 256] = acc;
                __syncthreads();
                if (!kh) { const f32x4 o = acc + part[tid]; const int c = sl * 8 + r;
                    const unsigned long long pk = (c < NCMP) ? ((unsigned long long)pk2(o.x, o.y) | ((unsigned long long)pk2(o.z, o.w) << 32)) : 0ull;
                    *(GAS unsigned long long*)(outp + ((size_t)bg * 256 + c) * 128 + e4) = pk; }
            }
            __syncthreads();
        }
        if (BOTH(3)) xcd_barrier(bar, wave);
    }

    if (IN(4)) for (int rep_ = 0; rep_ < (((REPEAT_MASK) >> 4) & 1) + 1; ++rep_) {
#ifdef STAMP_MODE
        if (STAMP_MODE == 2 && STAMPS && tid == 0) STAMPS[0] = __builtin_amdgcn_s_memrealtime();
#endif
        att::AttnBufs P{Qb, KCMP, VCMP, 256, rel_bias, SELM, SELM, GATES, OCb, OWb, Hb, STAMPS};
        for (int it = vcu; it < 256; it += G) { const int bg = it >> 6, qb = it & 63; att::attn_item<2>(lds, P, bg >> 1, bg & 1, 64 * qb, 64 * qb + 32, tid, lane, wave); }
#ifdef STAMP_MODE
        if (STAMP_MODE == 2 && STAMPS && tid == 0) STAMPS[6] = __builtin_amdgcn_s_memrealtime();
#endif
        if (BOTH(4)) xcd_barrier(bar, wave);
#ifdef STAMP_MODE
        if (STAMP_MODE == 2 && STAMPS && tid == 0) STAMPS[7] = __builtin_amdgcn_s_memrealtime();
#endif
    }
    if (IN(5)) for (int rep_ = 0; rep_ < (((REPEAT_MASK) >> 5) & 1) + 1; ++rep_) {
#ifdef STAMP_MODE
        if (STAMP_MODE == 0 && STAMPS && tid == 0) STAMPS[0] = __builtin_amdgcn_s_memrealtime();
#endif
        att::AttnBufs P{Qb, KVb + 2 * KVSZ, KVb + 3 * KVSZ, T_, rel_bias, SELM, SELM, GATES, OCb, OWb, Hb, STAMPS};
        for (int it = vcu; it < 256; it += G) { const int bg = it >> 6, pp = it & 63; att::attn_item<0>(lds, P, bg >> 1, bg & 1, 32 * pp, 32 * (127 - pp), tid, lane, wave); }
#ifdef STAMP_MODE
        if (STAMP_MODE == 0 && STAMPS && tid == 0) STAMPS[6] = __builtin_amdgcn_s_memrealtime();
#endif
        if (BOTH(5)) xcd_barrier(bar, wave);
#ifdef STAMP_MODE
        if (STAMP_MODE == 0 && STAMPS && tid == 0) STAMPS[7] = __builtin_amdgcn_s_memrealtime();
#endif
    }

    if (IN(6)) for (int rep_ = 0; rep_ < (((REPEAT_MASK) >> 6) & 1) + 1; ++rep_) {
        pg8::Gemm g{Hb, WoT, M_, D_, 2048, 2048, 2048}; pg8::StaticOrder S; S.init(M_, D_, G, bx);
        pg8::EpiF32 E{out, D_};
        pg8::gemm_phase<pg8::EpiF32, pg8::StaticOrder, true, true>(lds, g, S, E, wave);
        if (BOTH(6)) xcd_barrier(bar, wave);
    }

    if (IN(7)) for (int rep_ = 0; rep_ < (((REPEAT_MASK) >> 7) & 1) + 1; ++rep_) {
        for (int m = gw; m < M_; m += NGW) {
            GAS f32x4* mr = (GAS f32x4*)(out + (size_t)m * D_) + lane; const GAS f32x4* xr = (const GAS f32x4*)(x + (size_t)m * D_) + lane;
            const GAS f32x4* g1 = (const GAS f32x4*)g_post_mix + lane; const GAS f32x4* g2 = (const GAS f32x4*)g_pre_ffn + lane;
            f32x4 v[8]; float s = 0.f;
#pragma unroll
            for (int j = 0; j < 8; ++j) { v[j] = mr[64 * j]; s += (v[j].x * v[j].x + v[j].y * v[j].y) + (v[j].z * v[j].z + v[j].w * v[j].w); }
            const float r1 = rsqrtf(wave_sum(s) * (1.f / D_) + EPS); float s2 = 0.f;
#pragma unroll
            for (int j = 0; j < 8; ++j) { const f32x4 g = g1[64 * j], xx = xr[64 * j];
                v[j].x = xx.x + (v[j].x * r1) * g.x; v[j].y = xx.y + (v[j].y * r1) * g.y; v[j].z = xx.z + (v[j].z * r1) * g.z; v[j].w = xx.w + (v[j].w * r1) * g.w;
                mr[64 * j] = v[j]; s2 += (v[j].x * v[j].x + v[j].y * v[j].y) + (v[j].z * v[j].z + v[j].w * v[j].w); }
            const float r2 = rsqrtf(wave_sum(s2) * (1.f / D_) + EPS);
            GAS unsigned long long* o8 = (GAS unsigned long long*)(Hb + (size_t)m * D_) + lane;
#pragma unroll
            for (int j = 0; j < 8; ++j) { const f32x4 g = g2[64 * j];
                o8[64 * j] = (unsigned long long)pk2((v[j].x * r2) * g.x, (v[j].y * r2) * g.y) | ((unsigned long long)pk2((v[j].z * r2) * g.z, (v[j].w * r2) * g.w) << 32); }
        }
        if (BOTH(7)) xcd_barrier(bar, wave);
    }

    if (IN(8)) for (int rep_ = 0; rep_ < (((REPEAT_MASK) >> 8) & 1) + 1; ++rep_) {
        pg8::Gemm g{Hb, WupT, M_, DFF, D_, D_, D_}; pg8::StaticOrder S; S.init(M_, DFF, G, bx);
        pg8::EpiRelu2Bf16 E{Ub, DFF};
        pg8::gemm_phase<pg8::EpiRelu2Bf16, pg8::StaticOrder, true, true>(lds, g, S, E, wave);
        if (BOTH(8)) xcd_barrier(bar, wave);
    }

    if (IN(9)) for (int rep_ = 0; rep_ < (((REPEAT_MASK) >> 9) & 1) + 1; ++rep_) {
        pg8::Gemm g{Ub, WdnT, M_, D_, DFF, DFF, DFF}; pg8::StaticOrder S; S.init(M_, D_, G, bx);
        pg8::EpiF32 E{Fb, D_};
        pg8::gemm_phase<pg8::EpiF32, pg8::StaticOrder, true, true>(lds, g, S, E, wave);
        if (BOTH(9)) xcd_barrier(bar, wave);
    }

#ifdef STAMP_MODE
    if (IN(10) && bx == 0 && tid == 0) {
        const unsigned long long* st = (const unsigned long long*)(ws + WS_CTL + 110 * 1024);
        const unsigned long long a_ = __hip_atomic_load(st + STAMP_A, __ATOMIC_RELAXED, __HIP_MEMORY_SCOPE_AGENT), b_ = __hip_atomic_load(st + STAMP_B, __ATOMIC_RELAXED, __HIP_MEMORY_SCOPE_AGENT);
        MISC[20] = (unsigned)(b_ - a_);
    }
#endif
    if (IN(10)) for (int rep_ = 0; rep_ < (((REPEAT_MASK) >> 10) & 1) + 1; ++rep_) {
        for (int m = gw; m < M_; m += NGW) {
            const GAS f32x4* fr = (const GAS f32x4*)(Fb + (size_t)m * D_) + lane; GAS f32x4* orow = (GAS f32x4*)(out + (size_t)m * D_) + lane;
            const GAS f32x4* g1 = (const GAS f32x4*)g_post_ffn + lane;
            f32x4 v[8]; float s = 0.f;
#pragma unroll
            for (int j = 0; j < 8; ++j) { v[j] = fr[64 * j]; s += (v[j].x * v[j].x + v[j].y * v[j].y) + (v[j].z * v[j].z + v[j].w * v[j].w); }
            const float r1 = rsqrtf(wave_sum(s) * (1.f / D_) + EPS);
#pragma unroll
            for (int j = 0; j < 8; ++j) { const f32x4 g = g1[64 * j]; f32x4 xx = orow[64 * j];
                xx.x = xx.x + (v[j].x * r1) * g.x; xx.y = xx.y + (v[j].y * r1) * g.y; xx.z = xx.z + (v[j].z * r1) * g.z; xx.w = xx.w + (v[j].w * r1) * g.w;
                orow[64 * j] = xx; }
        }
    }
#ifdef STAMP_MODE
    if (IN(10)) { __syncthreads(); if (bx == 0 && tid == 0) { VM_WAIT(); out[0] += (float)MISC[20] * 0.0002f; } }
#endif
#undef IN
#undef BOTH
#undef lane
#undef tid
}

__device__ __forceinline__ float block_max(float v, float* red) {
  for (int o = 32; o > 0; o >>= 1) v = fmaxf(v, __shfl_xor(v, o));
  __syncthreads();
  if ((threadIdx.x & 63) == 0) red[threadIdx.x >> 6] = v;
  __syncthreads();
  return fmaxf(fmaxf(red[0], red[1]), fmaxf(red[2], red[3]));
}
__device__ __forceinline__ float block_sum(float v, float* red) {
  for (int o = 32; o > 0; o >>= 1) v += __shfl_xor(v, o);
  __syncthreads();
  if ((threadIdx.x & 63) == 0) red[threadIdx.x >> 6] = v;
  __syncthreads();
  return (red[0] + red[1]) + (red[2] + red[3]);
}
__global__ __launch_bounds__(256) void cmp_attn_ref(const bf16* Qb, const bf16* KCMP, const bf16* VCMP, const float* rel_bias, bf16* OC, unsigned long long* selmask) {
  const int id = blockIdx.x, t = id % T_, g = (id / T_) % NKV, b = id / (T_ * NKV);
  const int tid = threadIdx.x;
  const size_t row = (size_t)b * T_ + t;
  __shared__ float q[4][HD];
  __shared__ float p[4][256];
  __shared__ float red[4];
  for (int i = tid; i < 512; i += 256) q[i >> 7][i & 127] = bf2f(Qb[row * 1024 + (g * 4 + (i >> 7)) * HD + (i & 127)]);
  __syncthreads();
  const int c = tid;
  const bool valid = (c < NCMP) && (16 * c + 31 <= t);
  float s[4] = {NEGV, NEGV, NEGV, NEGV};
  if (valid) {
    const int bk = rel_bucket(t - (16 * c + 31));
    const bf16* kr = KCMP + ((size_t)(b * NKV + g) * 256 + c) * HD;
    float a0 = 0.f, a1 = 0.f, a2 = 0.f, a3 = 0.f;
    for (int d = 0; d < HD; ++d) { const float kvv = bf2f(kr[d]); a0 += q[0][d] * kvv; a1 += q[1][d] * kvv; a2 += q[2][d] * kvv; a3 += q[3][d] * kvv; }
    s[0] = a0 + rel_bias[(g * 4 + 0) * 32 + bk] * LOG2E;
    s[1] = a1 + rel_bias[(g * 4 + 1) * 32 + bk] * LOG2E;
    s[2] = a2 + rel_bias[(g * 4 + 2) * 32 + bk] * LOG2E;
    s[3] = a3 + rel_bias[(g * 4 + 3) * 32 + bk] * LOG2E;
  }
#pragma unroll
  for (int h = 0; h < 4; ++h) {
    const float m = block_max(s[h], red);
    const float e = valid ? exp2f(s[h] - m) : 0.f;
    const float l = block_sum(e, red);
    p[h][c] = valid ? e / l : 0.f;
  }
  __syncthreads();
  {
    const int d = tid & 127, hp = tid >> 7;
    const bf16* vb = VCMP + (size_t)(b * NKV + g) * 256 * HD;
    float o0 = 0.f, o1 = 0.f;
    for (int cc = 0; cc < NCMP; ++cc) { const float vv = bf2f(vb[cc * HD + d]); o0 += p[hp * 2][cc] * vv; o1 += p[hp * 2 + 1][cc] * vv; }
    const int h0 = g * 4 + hp * 2;
    OC[row * 1024 + h0 * HD + d] = (bf16)f2bf(o0);
    OC[row * 1024 + (h0 + 1) * HD + d] = (bf16)f2bf(o1);
  }
  if (tid < 64) {
    const int j = tid, cur = t >> 6;
    float v = 0.f;
    for (int h = 0; h < 4; ++h)
      for (int cc = 4 * j - 1; cc <= 4 * j + 3; ++cc)
        if (cc >= 0 && cc < NCMP) v += p[h][cc];
    if (j == 0 || j == cur || j == cur - 1) v = FORCEV;
    if (j * 64 > t) v = NEGV;
    int rank = 0;
    for (int i = 0; i < 64; ++i) { const float vi = __shfl(v, i); rank += (vi > v || (vi == v && i < j)) ? 1 : 0; }
    const unsigned long long mk = __ballot(rank < TOPK);
    if (tid == 0) selmask[(size_t)(b * NKV + g) * T_ + t] = mk;
  }
}
template <int MODE>
__global__ __launch_bounds__(256) void attn_ref(const bf16* Qb, const bf16* KVb, const float* rel_bias, const unsigned long long* selmask, const float* GATES,
                                                const bf16* OC, bf16* OW, bf16* AO, int ao_ld) {
  const int id = blockIdx.x, t = id % T_, g = (id / T_) % NKV, b = id / (T_ * NKV);
  const int tid = threadIdx.x;
  const size_t row = (size_t)b * T_ + t;
  __shared__ float q[4][HD];
  __shared__ float sc[4][1024];
  __shared__ float red[4];
  __shared__ int blist[16];
  __shared__ int nblk;
  const bf16* Kb = KVb + (size_t)(MODE ? 4 : 2) * KVSZ + (size_t)(b * NKV + g) * T_ * HD;
  const bf16* Vb = KVb + (size_t)(MODE ? 5 : 3) * KVSZ + (size_t)(b * NKV + g) * T_ * HD;
  for (int i = tid; i < 512; i += 256) q[i >> 7][i & 127] = bf2f(Qb[row * 1024 + (g * 4 + (i >> 7)) * HD + (i & 127)]);
  if (MODE == 0 && tid == 0) {
    const unsigned long long mk = selmask[(size_t)(b * NKV + g) * T_ + t];
    int n = 0;
    for (int j = 0; j < NSEL; ++j) if (((mk >> j) & 1ull) && j * 64 <= t && n < 16) blist[n++] = j;
    nblk = n;
  }
  __syncthreads();
  const int kstart = t - (WIN - 1) < 0 ? 0 : t - (WIN - 1);
  const int nkeys = MODE ? (t - kstart + 1) : nblk * 64;
  for (int i = tid; i < nkeys; i += 256) {
    const int pos = MODE ? (kstart + i) : (blist[i >> 6] * 64 + (i & 63));
    const bool valid = pos <= t;
    float s0 = NEGV, s1 = NEGV, s2 = NEGV, s3 = NEGV;
    if (valid) {
      const bf16* kr = Kb + (size_t)pos * HD;
      float a0 = 0.f, a1 = 0.f, a2 = 0.f, a3 = 0.f;
      for (int d = 0; d < HD; ++d) { const float kvv = bf2f(kr[d]); a0 += q[0][d] * kvv; a1 += q[1][d] * kvv; a2 += q[2][d] * kvv; a3 += q[3][d] * kvv; }
      const int bk = rel_bucket(t - pos);
      s0 = a0 + rel_bias[(g * 4 + 0) * 32 + bk] * LOG2E;
      s1 = a1 + rel_bias[(g * 4 + 1) * 32 + bk] * LOG2E;
      s2 = a2 + rel_bias[(g * 4 + 2) * 32 + bk] * LOG2E;
      s3 = a3 + rel_bias[(g * 4 + 3) * 32 + bk] * LOG2E;
    }
    sc[0][i] = s0; sc[1][i] = s1; sc[2][i] = s2; sc[3][i] = s3;
  }
  __syncthreads();
#pragma unroll
  for (int h = 0; h < 4; ++h) {
    float m = NEGV;
    for (int i = tid; i < nkeys; i += 256) m = fmaxf(m, sc[h][i]);
    m = block_max(m, red);
    float l = 0.f;
    for (int i = tid; i < nkeys; i += 256) { const float sv = sc[h][i]; const float e = (sv > -1e29f) ? exp2f(sv - m) : 0.f; sc[h][i] = e; l += e; }
    l = block_sum(l, red);
    const float inv = 1.f / l;
    for (int i = tid; i < nkeys; i += 256) sc[h][i] *= inv;
  }
  __syncthreads();
  {
    const int d = tid & 127, hp = tid >> 7;
    float o0 = 0.f, o1 = 0.f;
    for (int i = 0; i < nkeys; ++i) {
      const int pos = MODE ? (kstart + i) : (blist[i >> 6] * 64 + (i & 63));
      if (pos <= t) { const float vv = bf2f(Vb[(size_t)pos * HD + d]); o0 += sc[hp * 2][i] * vv; o1 += sc[hp * 2 + 1][i] * vv; }
    }
    const int h0 = g * 4 + hp * 2;
    const size_t i0 = row * 1024 + h0 * HD + d, i1 = row * 1024 + (h0 + 1) * HD + d;
    if (MODE) { OW[i0] = (bf16)f2bf(o0); OW[i1] = (bf16)f2bf(o1); }
    else {
      const float* gr = GATES + row * 24;
      float r0 = gr[h0 * 3 + 0] * bf2f(OC[i0]) + gr[h0 * 3 + 1] * o0; r0 = r0 + gr[h0 * 3 + 2] * bf2f(OW[i0]);
      float r1 = gr[(h0 + 1) * 3 + 0] * bf2f(OC[i1]) + gr[(h0 + 1) * 3 + 1] * o1; r1 = r1 + gr[(h0 + 1) * 3 + 2] * bf2f(OW[i1]);
      AO[row * ao_ld + h0 * HD + d] = (bf16)f2bf(r0);
      AO[row * ao_ld + (h0 + 1) * HD + d] = (bf16)f2bf(r1);
    }
  }
}

static void launch_mega(const Args& a0, int lo, int hi, int li, int grid, hipStream_t stream) {
    Args a = a0; a.ph_lo = lo; a.ph_hi = hi; a.li = li; a.pad = 0;
    void* params[] = {&a};
    hipError_t e = hipLaunchCooperativeKernel((const void*)mega_fwd, dim3(grid), dim3(NWAVES * 64), params, LDS_BYTES, stream);
    if (e != hipSuccess) fprintf(stderr, "kernel_launch: cooperative launch failed: %s (grid %d)\n", hipGetErrorString(e), grid);
}


#ifndef DEBUG_CHECK
#define DEBUG_CHECK 0
#endif
#if DEBUG_CHECK
__global__ void cmp_bf16_k(const bf16* a, int lda, const bf16* b, int ldb, int rows, int cols, unsigned* maxerr) {
    float e = 0.f;
    for (size_t i = (size_t)blockIdx.x * blockDim.x + threadIdx.x; i < (size_t)rows * cols; i += (size_t)gridDim.x * blockDim.x) {
        const int r = (int)(i / cols), c = (int)(i % cols);
        const float d = fabsf(bf2f(a[(size_t)r * lda + c]) - bf2f(b[(size_t)r * ldb + c]));
        e = fmaxf(e, d == d ? d : 1e9f);
    }
    for (int o = 32; o > 0; o >>= 1) e = fmaxf(e, __shfl_xor(e, o));
    if ((threadIdx.x & 63) == 0) atomicMax(maxerr, __float_as_uint(e));
}
__global__ void cmp_mask_k(const unsigned long long* a, const unsigned long long* b, int n, unsigned* cnt) {
    const int i = blockIdx.x * blockDim.x + threadIdx.x;
    if (i < n) { const int t = i & 4095; const int cur = t >> 6; const unsigned long long causal = cur >= 63 ? ~0ull : ((1ull << (cur + 1)) - 1ull);
        if ((a[i] & causal) != (b[i] & causal)) atomicAdd(cnt, 1u); }
}
__global__ void flag_k(const unsigned* errs, float* out) {
    if (threadIdx.x == 0 && blockIdx.x == 0) {
        const float e1 = __uint_as_float(errs[0]), e2 = __uint_as_float(errs[1]), e4 = __uint_as_float(errs[3]); const unsigned n3 = errs[2];
        float code = 0.f, sev = 0.f; const float tol = 0.01f;
        if (e1 > tol) { code = 1.f; sev = e1 / tol; }
        else if (e2 > tol) { code = 2.f; sev = e2 / tol; }
        else if (n3 > 16u) { code = 3.f; sev = (float)n3 / 16.f; }
        else if (e4 > tol) { code = 4.f; sev = e4 / tol; }
        if (code > 0.f) { sev = sev > 9.f ? 9.f : sev; out[0] += 100.f * code + 10.f * floorf(sev); }
#if DEBUG_CHECK == 2
        out[0] += 1e4f * fmaxf(e1, fmaxf(e2, e4)); out[1] += (float)n3;
#endif
    }
}
#endif

extern "C" void kernel_launch(void* const* d_in, const int* in_sizes, int n_in, void* d_out, int out_size, void* d_ws, size_t ws_size, hipStream_t stream) {
    static int grid = 0;
    if (grid == 0) {
        if (n_in != 16 || ws_size < WS_END) { fprintf(stderr, "kernel_launch: unexpected n_in %d or ws_size %zu (< %zu)\n", n_in, ws_size, (size_t)WS_END); grid = -1; return; }
        int dev = 0, cus = 0, per_cu = 0;
        (void)hipGetDevice(&dev); (void)hipDeviceGetAttribute(&cus, hipDeviceAttributeMultiprocessorCount, dev);
        (void)hipFuncSetAttribute((const void*)mega_fwd, hipFuncAttributeMaxDynamicSharedMemorySize, LDS_BYTES);
        (void)hipOccupancyMaxActiveBlocksPerMultiprocessor(&per_cu, (const void*)mega_fwd, NWAVES * 64, LDS_BYTES);
        if (per_cu < 1) { fprintf(stderr, "kernel_launch: occupancy query says %d blocks per CU\n", per_cu); grid = -1; return; }
        grid = cus;
    }
    if (grid < 0) return;
    (void)hipMemsetAsync((char*)d_ws + WS_CTL, 0, CTL_ZERO_BYTES, stream);
    Args a{};
    for (int i = 0; i < 16; ++i) a.in[i] = (const float*)d_in[i];
    a.out = (float*)d_out; a.ws = (unsigned char*)d_ws;
#if DEBUG_CHECK
    unsigned char* ws = (unsigned char*)d_ws;
    const float* rel_bias = (const float*)d_in[8];
    unsigned* errs = (unsigned*)(ws + WS_CTL + 122880);
    bf16* TMP = (bf16*)(ws + WS_WIN);
    unsigned long long* SELMX = (unsigned long long*)(ws + WS_WIN + 20 * MiB);
    launch_mega(a, 0, 4, 0, grid, stream);
    attn_ref<1><<<B_ * NKV * T_, 256, 0, stream>>>((const bf16*)(ws + WS_Q), (const bf16*)(ws + WS_KV), rel_bias, (const unsigned long long*)(ws + WS_SELM),
                                                   (const float*)(ws + WS_GATES), (const bf16*)(ws + WS_OC), TMP, TMP, 1024);
    cmp_bf16_k<<<1024, 256, 0, stream>>>((const bf16*)(ws + WS_OW), 1024, TMP, 1024, M_, 1024, errs + 0);
    launch_mega(a, 4, 5, 1, grid, stream);
    cmp_attn_ref<<<B_ * NKV * T_, 256, 0, stream>>>((const bf16*)(ws + WS_Q), (const bf16*)(ws + WS_KCMP), (const bf16*)(ws + WS_VCMP), rel_bias, TMP, SELMX);
    cmp_bf16_k<<<1024, 256, 0, stream>>>((const bf16*)(ws + WS_OC), 1024, TMP, 1024, M_, 1024, errs + 1);
    cmp_mask_k<<<64, 256, 0, stream>>>((const unsigned long long*)(ws + WS_SELM), SELMX, 4 * T_, errs + 2);
    launch_mega(a, 5, 6, 2, grid, stream);
    attn_ref<0><<<B_ * NKV * T_, 256, 0, stream>>>((const bf16*)(ws + WS_Q), (const bf16*)(ws + WS_KV), rel_bias, (const unsigned long long*)(ws + WS_SELM),
                                                   (const float*)(ws + WS_GATES), (const bf16*)(ws + WS_OC), (bf16*)(ws + WS_OW), TMP, 1024);
    cmp_bf16_k<<<1024, 256, 0, stream>>>((const bf16*)(ws + WS_H), 2048, TMP, 1024, M_, 1024, errs + 3);
    launch_mega(a, 6, 11, 3, grid, stream);
    flag_k<<<1, 64, 0, stream>>>(errs, (float*)d_out);
#elif defined(SPLIT_A_HI)
    launch_mega(a, 0, SPLIT_A_HI, 0, grid, stream);
    launch_mega(a, SPLIT_B_LO, 11, 1, grid, stream);
#else
    launch_mega(a, 0, 11, 0, grid, stream);
#endif
}
```
